# Optimizing an MI355X kernel written in HIP

```python
import jax, jax.numpy as jnp
from jax import lax
import numpy as np

D_MODEL = 2048
BATCH = 8
SEQ = 4096
DEPTH = 4

N_MIXERS = 2
N_HEADS = 16
HEAD_DIM = D_MODEL // N_HEADS
D_FF = 5632
BLOCK_Q = 128
EPS = 1e-6
FFN_RES = 0.5

kernel_name = "fox_stickbreak_macaron_hybrid"


def rms_norm(x, g):
    xf = x.astype(jnp.float32)
    y = xf * lax.rsqrt(jnp.mean(xf * xf, axis=-1, keepdims=True) + EPS)
    return (y * g.astype(jnp.float32)).astype(x.dtype)


def swiglu(h, w_in, w_out):
    gate, up = jnp.split(h @ w_in, 2, axis=-1)
    return (jax.nn.silu(gate) * up) @ w_out


def split_heads(t):
    b, s, _ = t.shape
    return t.reshape(b, s, N_HEADS, HEAD_DIM).transpose(0, 2, 1, 3)


def merge_heads(t):
    b, h, s, d = t.shape
    return t.transpose(0, 2, 1, 3).reshape(b, s, h * d)


def fox_attention(h, w_in, b_f, qk_g):
    seq = h.shape[1]
    proj = h @ w_in
    q, k, v, f_logit = jnp.split(proj, [D_MODEL, 2 * D_MODEL, 3 * D_MODEL], axis=-1)
    q = rms_norm(split_heads(q), qk_g[0])
    k = rms_norm(split_heads(k), qk_g[1])
    v = split_heads(v)
    log_f = jax.nn.log_sigmoid((f_logit + b_f).astype(jnp.float32))
    c = jnp.cumsum(log_f, axis=1).transpose(0, 2, 1)
    scale = HEAD_DIM ** -0.5
    outs = []
    for blk in range(seq // BLOCK_Q):
        start, end = blk * BLOCK_Q, (blk + 1) * BLOCK_Q
        s = jnp.einsum('bhqd,bhkd->bhqk', q[:, :, start:end], k[:, :, :end],
                       preferred_element_type=jnp.float32) * scale
        s = s + c[:, :, start:end, None] - c[:, :, None, :end]
        mask = (start + jnp.arange(BLOCK_Q))[:, None] >= jnp.arange(end)[None, :]
        p = jax.nn.softmax(jnp.where(mask, s, -jnp.inf), axis=-1)
        outs.append(jnp.einsum('bhqk,bhkd->bhqd', p.astype(v.dtype), v[:, :, :end]))
    return merge_heads(jnp.concatenate(outs, axis=2))


def stick_breaking_attention(h, w_in):
    seq = h.shape[1]
    q, k, v = jnp.split(h @ w_in, 3, axis=-1)
    q, k, v = split_heads(q), split_heads(k), split_heads(v)
    scale = HEAD_DIM ** -0.5
    outs = []
    for blk in range(seq // BLOCK_Q):
        start, end = blk * BLOCK_Q, (blk + 1) * BLOCK_Q
        z = jnp.einsum('bhqd,bhkd->bhqk', q[:, :, start:end], k[:, :, :end],
                       preferred_element_type=jnp.float32) * scale
        mask = jnp.arange(end)[None, :] < (start + jnp.arange(BLOCK_Q))[:, None]
        log_1m_beta = jnp.where(mask, jax.nn.log_sigmoid(-z), 0.0)
        tail = lax.cumsum(log_1m_beta, axis=3, reverse=True) - log_1m_beta
        log_a = jnp.where(mask, jax.nn.log_sigmoid(z) + tail, -jnp.inf)
        a = jnp.exp(log_a)
        outs.append(jnp.einsum('bhqk,bhkd->bhqd', a.astype(v.dtype), v[:, :, :end]))
    return merge_heads(jnp.concatenate(outs, axis=2))


def setup_inputs(seed: int = 0) -> dict:
    key = jax.random.key(seed)
    ks = jax.random.split(key, 10)
    n_fox = len(range(0, DEPTH, N_MIXERS))
    n_sb = DEPTH - n_fox
    f32 = jnp.float32
    x = jax.random.normal(ks[0], (BATCH, SEQ, D_MODEL), f32)
    norm_g = 1.0 + 0.02 * jax.random.normal(ks[1], (DEPTH, 3, D_MODEL), f32)
    ffn_w_in = jax.random.normal(ks[2], (DEPTH, 2, D_MODEL, 2 * D_FF), f32) * D_MODEL ** -0.5
    ffn_w_out = jax.random.normal(ks[3], (DEPTH, 2, D_FF, D_MODEL), f32) * D_FF ** -0.5
    fox_w_in = jax.random.normal(ks[4], (n_fox, D_MODEL, 3 * D_MODEL + N_HEADS), f32) * D_MODEL ** -0.5
    fox_b_f = 2.0 + jax.random.normal(ks[5], (n_fox, N_HEADS), f32)
    fox_qk_g = 1.0 + 0.02 * jax.random.normal(ks[6], (n_fox, 2, HEAD_DIM), f32)
    sb_w_in = jax.random.normal(ks[7], (n_sb, D_MODEL, 3 * D_MODEL), f32) * D_MODEL ** -0.5
    w_o = jax.random.normal(ks[8], (DEPTH, D_MODEL, D_MODEL), f32) * D_MODEL ** -0.5
    return {"x": x, "norm_g": norm_g, "ffn_w_in": ffn_w_in, "ffn_w_out": ffn_w_out,
            "fox_w_in": fox_w_in, "fox_b_f": fox_b_f, "fox_qk_g": fox_qk_g,
            "sb_w_in": sb_w_in, "w_o": w_o}


def reference(x, norm_g, ffn_w_in, ffn_w_out, fox_w_in, fox_b_f, fox_qk_g, sb_w_in, w_o):
    for i in range(DEPTH):
        g = norm_g[i]
        x = x + FFN_RES * swiglu(rms_norm(x, g[0]), ffn_w_in[i, 0], ffn_w_out[i, 0])
        h = rms_norm(x, g[1])
        j = i // N_MIXERS
        if i % N_MIXERS == 0:
            m = fox_attention(h, fox_w_in[j], fox_b_f[j], fox_qk_g[j])
        else:
            m = stick_breaking_attention(h, sb_w_in[j])
        x = x + m @ w_o[i]
        x = x + FFN_RES * swiglu(rms_norm(x, g[2]), ffn_w_in[i, 1], ffn_w_out[i, 1])
    return x
```

```cpp
#include <hip/hip_runtime.h>
#include <cstdio>
#include <cstdint>
namespace pg8 {
#define PG8_LAS __attribute__((address_space(3)))
typedef unsigned short bf16_t;
typedef short bf16x8 __attribute__((ext_vector_type(8)));
typedef float f32x4 __attribute__((ext_vector_type(4)));
typedef unsigned u32x4 __attribute__((ext_vector_type(4)));
constexpr int BM = 256, BK = 64, HALF = 128, HTB = HALF * BK * 2  , STAGE_BYTES = 8 * HTB, NXCD = 8, WGM = 8;

__host__ __device__ __forceinline__ int lds_byte(int r, int c) { const int st = (r >> 4) * 2 + (c >> 5), rr = r & 15, cc = c & 31, ob = rr * 64 + cc * 2; return st * 1024 + (ob ^ (((ob >> 9) & 1) << 5)); }
__host__ __device__ __forceinline__ void stage_rc(int b, int& R, int& C) { const int st = b / 1024, sb = b % 1024, swz = sb ^ (((sb >> 9) & 1) << 5); R = (st >> 1) * 16 + swz / 64; C = (st & 1) * 32 + (swz % 64) / 2; }
__host__ __device__ __forceinline__ int perm32(int rho) { const int n = rho >> 4, i = rho & 15; return 8 * (i >> 2) + 4 * n + (i & 3); }

struct Unit { int pm, pn; };
struct Gemm { const bf16_t* A; const bf16_t* Bt; int M, N, K; int atile, btile; };

struct StaticOrder {
    int nM, nN, nwg, G, c, i0, i1, wgm;
    __host__ __device__ void init(int M, int N, int G_, int c_, int i0_ = 0, int i1_ = 0, int wgm_ = WGM) { nM = M / BM; nN = N / BM; nwg = nM * nN; G = G_; c = c_; i0 = i0_; i1 = i1_; wgm = wgm_; }
    __host__ __device__ bool next(int i, Unit& u) const {
        i += i0; if (i1 > 0 && i >= i1) return false;
        const long L = (long)i * G + c; if (L >= nwg) return false;
        int wgid = (int)L; { const int q = nwg / NXCD, r = nwg % NXCD, xcd = wgid % NXCD, off = wgid / NXCD; wgid = (xcd < r ? xcd * (q + 1) : r * (q + 1) + (xcd - r) * q) + off; }
        const int nig = wgm * nN, gid = wgid / nig, fm = gid * wgm, gsz = (nM - fm) < wgm ? (nM - fm) : wgm;
        u.pm = fm + ((wgid % nig) % gsz); u.pn = (wgid % nig) / gsz; return true;
    }
    __device__ __forceinline__ void a_ready(const Unit&) const {}
    __device__ __forceinline__ void done(const Unit&) const {}
};
struct RstdOrder : StaticOrder {
    const float* rstd; PG8_LAS unsigned char* tab;
    __device__ __forceinline__ void a_ready(const Unit& u) const {
        int t_ = threadIdx.x; asm volatile("" : "+v"(t_));
        if (__builtin_amdgcn_readfirstlane(t_ >> 6) == 0) {
            const float* src = rstd + (size_t)u.pm * BM + (t_ & 63) * 4;
            __builtin_amdgcn_global_load_lds((const unsigned*)src, (PG8_LAS unsigned*)(tab + ((u.pm >> 3) & 1) * 1024), 16, 0, 0); }
    }
};


__device__ __forceinline__ unsigned cvt_pk_bf16(float lo, float hi) { unsigned r; asm volatile("v_cvt_pk_bf16_f32 %0, %1, %2" : "=v"(r) : "v"(lo), "v"(hi)); return r; }
constexpr int SSQ_W = 32;
constexpr float RMS_EPS = 1e-6f, INV_DM = 1.0f / 2048.0f;
struct EpiSwiGLU {
    static constexpr bool PERM = true, AFTER_DRAIN = false, ACC_INIT = false;
    bf16_t* O; int ldo; const PG8_LAS float* rtab;
    __device__ __forceinline__ void operator()(const f32x4 (&acc)[2][2][4][2], const Unit& u, int wr, int wc, int fr, int fq) const {
        const int row0 = u.pm * BM + wr * 64 + fr, col0 = u.pn * HALF + wc * 32 + 8 * fq;
        float rsv[2][4];
#pragma unroll
        for (int ai = 0; ai < 2; ++ai)
#pragma unroll
            for (int m = 0; m < 4; ++m) rsv[ai][m] = rtab[((u.pm >> 3) & 1) * 256 + ai * HALF + wr * 64 + m * 16 + fr];
#pragma unroll
        for (int ai = 0; ai < 2; ++ai)
#pragma unroll
            for (int m = 0; m < 4; ++m) { const int row = row0 + ai * HALF + m * 16; const float rs = rsv[ai][m];
                float o[8];
#pragma unroll
                for (int n = 0; n < 2; ++n)
#pragma unroll
                    for (int i = 0; i < 4; ++i) { const float g = acc[ai][0][m][n][i] * rs, up = acc[ai][1][m][n][i] * rs;
                        const float e = __builtin_amdgcn_exp2f(g * -1.4426950408889634f); o[n * 4 + i] = g * __builtin_amdgcn_rcpf(1.0f + e) * up; }
                u32x4 w; w.x = cvt_pk_bf16(o[0], o[1]); w.y = cvt_pk_bf16(o[2], o[3]); w.z = cvt_pk_bf16(o[4], o[5]); w.w = cvt_pk_bf16(o[6], o[7]);
                *(u32x4*)(O + (((size_t)u.pm * (ldo / 64) + 2 * u.pn + (wc >> 1)) * BM + (row - u.pm * BM)) * 64 + (wc & 1) * 32 + 8 * fq) = w; }
    }
};
struct EpiResid {
    static constexpr bool PERM = true, AFTER_DRAIN = false, ACC_INIT = true;
    float* out; bf16_t* xh; float* ssq; float alpha, inv_alpha; int ldc; bool final_;
    __device__ __forceinline__ static f32x4 up4(unsigned a, unsigned b) { return (f32x4){__builtin_bit_cast(float, a << 16), __builtin_bit_cast(float, a & 0xffff0000u), __builtin_bit_cast(float, b << 16), __builtin_bit_cast(float, b & 0xffff0000u)}; }
    __device__ __forceinline__ void init(f32x4 (&acc)[2][2][4][2], const Unit& u, int wr, int wc, int fr, int fq) const {
        const int row0 = u.pm * BM + wr * 64 + fr, col0 = u.pn * BM + wc * 32 + 8 * fq;
#pragma unroll
        for (int ai = 0; ai < 2; ++ai)
#pragma unroll
            for (int m = 0; m < 4; ++m) { const size_t off = (size_t)(row0 + ai * HALF + m * 16) * ldc + col0;
#pragma unroll
                for (int bj = 0; bj < 2; ++bj) { const u32x4 h = *(const u32x4*)(xh + off + bj * HALF);
                    acc[ai][bj][m][0] = up4(h.x, h.y) * inv_alpha; acc[ai][bj][m][1] = up4(h.z, h.w) * inv_alpha; } }
    }
    __device__ __forceinline__ void operator()(const f32x4 (&acc)[2][2][4][2], const Unit& u, int wr, int wc, int fr, int fq) const {
        const int row0 = u.pm * BM + wr * 64 + fr, col0 = u.pn * BM + wc * 32 + 8 * fq;
        float sv[2][4];
#pragma unroll
        for (int ai = 0; ai < 2; ++ai)
#pragma unroll
            for (int m = 0; m < 4; ++m) { const int row = row0 + ai * HALF + m * 16; const size_t off = (size_t)row * ldc + col0; float s = 0.f;
#pragma unroll
                for (int bj = 0; bj < 2; ++bj) { const f32x4 o0 = acc[ai][bj][m][0] * alpha, o1 = acc[ai][bj][m][1] * alpha;
                    s += ((o0[0] * o0[0] + o0[1] * o0[1]) + (o0[2] * o0[2] + o0[3] * o0[3])) + ((o1[0] * o1[0] + o1[1] * o1[1]) + (o1[2] * o1[2] + o1[3] * o1[3]));
                    if (final_) { *(f32x4*)(out + off + bj * HALF) = o0; *(f32x4*)(out + off + bj * HALF + 4) = o1; }
                    else { u32x4 h; h.x = cvt_pk_bf16(o0[0], o0[1]); h.y = cvt_pk_bf16(o0[2], o0[3]); h.z = cvt_pk_bf16(o1[0], o1[1]); h.w = cvt_pk_bf16(o1[2], o1[3]);
                           *(u32x4*)(xh + off + bj * HALF) = h; } }
                s += __shfl_xor(s, 16); s += __shfl_xor(s, 32); sv[ai][m] = s; }
        if (!final_) {
#pragma unroll
            for (int ai = 0; ai < 2; ++ai) { const float s = fq == 0 ? sv[ai][0] : (fq == 1 ? sv[ai][1] : (fq == 2 ? sv[ai][2] : sv[ai][3]));
                ssq[(size_t)(row0 + ai * HALF + fq * 16) * SSQ_W + u.pn * 4 + wc] = s; } }
    }
};
struct EpiQKV {
    static constexpr bool PERM = true, AFTER_DRAIN = false, ACC_INIT = false;
    bf16_t* Q; size_t tstride; const PG8_LAS float* rtab; float qscale; const float* qkg; PG8_LAS float* tab;
    __device__ __forceinline__ void operator()(const f32x4 (&acc)[2][2][4][2], const Unit& u, int wr, int wc, int fr, int fq) const {
        const int which = u.pn >> 3, hp = u.pn & 7;
        bf16_t* dst = Q + (size_t)which * tstride; const float sc = which == 0 ? qscale : 1.0f;
        const int row0 = u.pm * BM + wr * 64 + fr, b = u.pm >> 4, s0 = (u.pm & 15) * BM + wr * 64 + fr, d0 = wc * 32 + 8 * fq;
        float rsv[2][4];
#pragma unroll
        for (int ai = 0; ai < 2; ++ai)
#pragma unroll
            for (int m = 0; m < 4; ++m) rsv[ai][m] = rtab[((u.pm >> 3) & 1) * 256 + ai * HALF + wr * 64 + m * 16 + fr];
        const bool norm = (qkg != nullptr) && which < 2;
        f32x4 g0 = (f32x4){1.f, 1.f, 1.f, 1.f}, g1 = g0;
        if (norm) {
            g0 = *(const f32x4*)(qkg + which * 128 + d0); g1 = *(const f32x4*)(qkg + which * 128 + d0 + 4);
#pragma unroll
            for (int ai = 0; ai < 2; ++ai)
#pragma unroll
                for (int m = 0; m < 4; ++m) { const float rs2 = rsv[ai][m] * rsv[ai][m];
#pragma unroll
                    for (int bj = 0; bj < 2; ++bj) { const f32x4 a0 = acc[ai][bj][m][0], a1 = acc[ai][bj][m][1];
                        float s = ((a0[0] * a0[0] + a0[1] * a0[1]) + (a0[2] * a0[2] + a0[3] * a0[3])) + ((a1[0] * a1[0] + a1[1] * a1[1]) + (a1[2] * a1[2] + a1[3] * a1[3]));
                        s += __shfl_xor(s, 16); s += __shfl_xor(s, 32);
                        if (fq == 0) tab[(ai * HALF + wr * 64 + m * 16 + fr) * 8 + bj * 4 + wc] = s * rs2; } }
            asm volatile("s_waitcnt lgkmcnt(0)" ::: "memory"); __builtin_amdgcn_s_barrier(); asm volatile("" ::: "memory");
        }
#pragma unroll
        for (int ai = 0; ai < 2; ++ai)
#pragma unroll
            for (int m = 0; m < 4; ++m) { const int s = s0 + ai * HALF + m * 16; const float rs = rsv[ai][m] * sc;
#pragma unroll
                for (int bj = 0; bj < 2; ++bj) { const int h = 2 * hp + bj; float rn = rs;
                    if (norm) { const f32x4 t = *(const PG8_LAS f32x4*)(tab + (ai * HALF + wr * 64 + m * 16 + fr) * 8 + bj * 4); rn = rs / sqrtf(((t[0] + t[1]) + (t[2] + t[3])) * (1.0f / 128.0f) + RMS_EPS); }
                    const f32x4 v0 = acc[ai][bj][m][0] * rn * g0, v1 = acc[ai][bj][m][1] * rn * g1;
                    u32x4 w; w.x = cvt_pk_bf16(v0[0], v0[1]); w.y = cvt_pk_bf16(v0[2], v0[3]); w.z = cvt_pk_bf16(v1[0], v1[1]); w.w = cvt_pk_bf16(v1[2], v1[3]);
                    *(u32x4*)(dst + ((size_t)(b * 16 + h) * 4096 + s) * 128 + d0) = w; } }
    }
};

template <class Epi, class Sched, bool ALIGN_EPI = false, bool SP2 = false>
__device__ __forceinline__ void gemm_phase(PG8_LAS unsigned char* lds, const Gemm g, const Sched& S, const Epi& E) {
    int tid_ = threadIdx.x; asm volatile("" : "+v"(tid_));
    const int tid = tid_, wid = __builtin_amdgcn_readfirstlane(tid >> 6), lane = tid & 63, wr = wid >> 2, wc = wid & 3, fr = lane & 15, fq = lane >> 4;
    const int K = g.K, nt = K / BK;
    unsigned voffA[2], voffB[2];
#pragma unroll
    for (int i = 0; i < 2; ++i) { int R, C; stage_rc(tid * 16 + i * 8192, R, C); const int Rb = Epi::PERM ? ((R & ~31) + perm32(R & 31)) : R;
        voffA[i] = (unsigned)(R * (g.atile ? BK : K) + C) * 2u; voffB[i] = (unsigned)(Rb * (g.btile ? BK : K) + C) * 2u; }
    const size_t kstepA = g.atile ? (size_t)(BM * BK * 2) : (size_t)(BK * 2), kstepB = g.btile ? (size_t)(BM * BK * 2) : (size_t)(BK * 2);
    const size_t hstepA = g.atile ? (size_t)(HALF * BK * 2) : (size_t)HALF * K * 2, hstepB = g.btile ? (size_t)(HALF * BK * 2) : (size_t)HALF * K * 2;
    const size_t tstep = (size_t)BM * K * 2;
    const unsigned ldsw = (unsigned)wid * 1024u;
    const int aoff = lds_byte(wr * 64 + fr, fq * 8), boff = lds_byte(wc * 32 + fr, fq * 8);
#define PG8_SA(b, h) (((b) * 2 + (h)) * HTB)
#define PG8_SB(b, h) ((4 + (b) * 2 + (h)) * HTB)
#define PG8_STAGE(bufoff, gbase, voff) do { _Pragma("unroll") for (int _i = 0; _i < 2; ++_i) \
        __builtin_amdgcn_global_load_lds((const unsigned*)((const char*)(gbase) + (voff)[_i]), (PG8_LAS unsigned*)(lds + (bufoff) + ldsw + _i * 8192), 16, 0, 0); } while (0)
#define PG8_LDA(dst, b, h) do { _Pragma("unroll") for (int m = 0; m < 4; ++m) _Pragma("unroll") for (int k = 0; k < 2; ++k) dst[m][k] = *(const PG8_LAS bf16x8*)(lds + PG8_SA(b, h) + aoff + m * 2048 + k * 1024); } while (0)
#define PG8_LDB(dst, b, h) do { _Pragma("unroll") for (int n = 0; n < 2; ++n) _Pragma("unroll") for (int k = 0; k < 2; ++k) dst[n][k] = *(const PG8_LAS bf16x8*)(lds + PG8_SB(b, h) + boff + n * 2048 + k * 1024); } while (0)
#define PG8_MMA(ai, bj, At, Bt) do { __builtin_amdgcn_s_setprio(1); _Pragma("unroll") for (int m = 0; m < 4; ++m) _Pragma("unroll") for (int n = 0; n < 2; ++n) _Pragma("unroll") for (int k = 0; k < 2; ++k) \
        acc[ai][bj][m][n] = __builtin_amdgcn_mfma_f32_16x16x32_bf16(Bt[n][k], At[m][k], acc[ai][bj][m][n], 0, 0, 0); __builtin_amdgcn_s_setprio(0); } while (0)
#define PG8_WAIT_V(n) asm volatile("s_waitcnt vmcnt(" #n ")" ::: "memory")
#define PG8_WAIT_L(n) asm volatile("s_waitcnt lgkmcnt(" #n ")" ::: "memory")
#define PG8_BAR __builtin_amdgcn_s_barrier()
#define PG8_SCHED __builtin_amdgcn_sched_barrier(0)
    Unit cur, nxt; int ui = 0;
    if (!S.next(0, cur)) return;
    f32x4 acc[2][2][4][2];
    if constexpr (Epi::ACC_INIT) { E.init(acc, cur, wr, wc, fr, fq); } else {
#pragma unroll
    for (int a = 0; a < 2; ++a)
#pragma unroll
        for (int b = 0; b < 2; ++b)
#pragma unroll
            for (int m = 0; m < 4; ++m)
#pragma unroll
                for (int n = 0; n < 2; ++n) acc[a][b][m][n] = (f32x4){0.f, 0.f, 0.f, 0.f}; }
    bf16x8 At[4][2], B0[2][2], B1[2][2];
    const char* cA = (const char*)g.A + (size_t)cur.pm * tstep; const char* cB = (const char*)g.Bt + (size_t)cur.pn * tstep;
    S.a_ready(cur);
    if constexpr (SP2) {
        PG8_STAGE(PG8_SB(0, 0), cB, voffB); PG8_STAGE(PG8_SB(0, 1), cB + hstepB, voffB); PG8_STAGE(PG8_SA(0, 0), cA, voffA); PG8_STAGE(PG8_SA(0, 1), cA + hstepA, voffA);
        if (wr == 1) PG8_BAR;
        PG8_WAIT_V(2); PG8_BAR;
        PG8_STAGE(PG8_SB(1, 0), cB + kstepB, voffB); PG8_STAGE(PG8_SA(1, 0), cA + kstepA, voffA); PG8_STAGE(PG8_SB(1, 1), cB + hstepB + kstepB, voffB);
        PG8_WAIT_V(6); PG8_BAR;
    } else {
        PG8_STAGE(PG8_SB(0, 0), cB, voffB); PG8_STAGE(PG8_SA(0, 0), cA, voffA); PG8_STAGE(PG8_SB(0, 1), cB + hstepB, voffB); PG8_STAGE(PG8_SA(0, 1), cA + hstepA, voffA);
        if (wr == 1) PG8_BAR;
        PG8_WAIT_V(4); PG8_BAR;
        PG8_STAGE(PG8_SB(1, 0), cB + kstepB, voffB); PG8_STAGE(PG8_SA(1, 0), cA + kstepA, voffA); PG8_STAGE(PG8_SB(1, 1), cB + hstepB + kstepB, voffB);
        PG8_WAIT_V(6); PG8_BAR;
    }
    for (;;) {
        const bool has_next = S.next(ui + 1, nxt);
        const char* nA = has_next ? (const char*)g.A + (size_t)nxt.pm * tstep : cA; const char* nB = has_next ? (const char*)g.Bt + (size_t)nxt.pn * tstep : cB;
        for (int t = 0; t < nt; t += 2) {
            const bool last = (t == nt - 2);
            const char* a1 = cA + (size_t)(t + 1) * kstepA;
            const char* a2 = last ? nA : cA + (size_t)(t + 2) * kstepA; const char* b2 = last ? nB : cB + (size_t)(t + 2) * kstepB;
            const char* a3 = a2 + kstepA; const char* b3 = b2 + kstepB;
            if (last && has_next) S.a_ready(nxt);
            if constexpr (SP2) {
            PG8_LDB(B0, 0, 0); PG8_LDB(B1, 0, 1); PG8_SCHED; PG8_LDA(At, 0, 0); PG8_STAGE(PG8_SA(1, 1), a1 + hstepA, voffA);
            PG8_WAIT_V(8); PG8_WAIT_L(0); PG8_BAR; PG8_MMA(0, 0, At, B0); PG8_MMA(0, 1, At, B1); PG8_BAR; PG8_SCHED;
            PG8_LDA(At, 0, 1); PG8_STAGE(PG8_SB(0, 0), b2, voffB); PG8_STAGE(PG8_SB(0, 1), b2 + hstepB, voffB); PG8_STAGE(PG8_SA(0, 0), a2, voffA);
            PG8_WAIT_V(8); PG8_WAIT_L(0); PG8_BAR; PG8_MMA(1, 0, At, B0); PG8_MMA(1, 1, At, B1); PG8_BAR; PG8_SCHED;
            PG8_LDB(B0, 1, 0); PG8_LDB(B1, 1, 1); PG8_SCHED; PG8_LDA(At, 1, 0); PG8_STAGE(PG8_SA(0, 1), a2 + hstepA, voffA);
            PG8_WAIT_V(8); PG8_WAIT_L(0); PG8_BAR; PG8_MMA(0, 0, At, B0); PG8_MMA(0, 1, At, B1); PG8_BAR; PG8_SCHED;
            PG8_LDA(At, 1, 1); PG8_STAGE(PG8_SB(1, 0), b3, voffB); PG8_STAGE(PG8_SB(1, 1), b3 + hstepB, voffB); PG8_STAGE(PG8_SA(1, 0), a3, voffA);
            PG8_WAIT_V(8); PG8_WAIT_L(0); PG8_BAR; PG8_MMA(1, 0, At, B0); PG8_MMA(1, 1, At, B1); PG8_BAR; PG8_SCHED;
            } else {
            PG8_LDB(B0, 0, 0); PG8_SCHED; PG8_LDA(At, 0, 0); PG8_STAGE(PG8_SA(1, 1), a1 + hstepA, voffA);
            PG8_WAIT_L(8); PG8_BAR; PG8_WAIT_L(0); PG8_MMA(0, 0, At, B0); PG8_BAR; PG8_SCHED;
            PG8_LDB(B1, 0, 1); PG8_STAGE(PG8_SB(0, 0), b2, voffB);
            PG8_BAR; PG8_WAIT_L(0); PG8_MMA(0, 1, At, B1); PG8_BAR;
            PG8_LDA(At, 0, 1); PG8_STAGE(PG8_SA(0, 0), a2, voffA);
            PG8_BAR; PG8_WAIT_L(0); PG8_MMA(1, 0, At, B0); PG8_BAR; PG8_SCHED;
            PG8_STAGE(PG8_SB(0, 1), b2 + hstepB, voffB);
            PG8_WAIT_V(6); PG8_BAR; PG8_MMA(1, 1, At, B1); PG8_BAR;
            PG8_LDB(B0, 1, 0); PG8_SCHED; PG8_LDA(At, 1, 0); PG8_STAGE(PG8_SA(0, 1), a2 + hstepA, voffA);
            PG8_WAIT_L(8); PG8_BAR; PG8_WAIT_L(0); PG8_MMA(0, 0, At, B0); PG8_BAR; PG8_SCHED;
            PG8_LDB(B1, 1, 1); PG8_STAGE(PG8_SB(1, 0), b3, voffB);
            PG8_BAR; PG8_WAIT_L(0); PG8_MMA(0, 1, At, B1); PG8_BAR;
            PG8_LDA(At, 1, 1); PG8_STAGE(PG8_SA(1, 0), a3, voffA);
            PG8_BAR; PG8_WAIT_L(0); PG8_MMA(1, 0, At, B0); PG8_BAR; PG8_SCHED;
            PG8_STAGE(PG8_SB(1, 1), b3 + hstepB, voffB);
            PG8_WAIT_V(6); PG8_BAR; PG8_MMA(1, 1, At, B1); PG8_BAR;
            }
        }
        if constexpr (ALIGN_EPI) { if (wr == 0) PG8_BAR; }
        if constexpr (!Epi::AFTER_DRAIN) { E(acc, cur, wr, wc, fr, fq); S.done(cur); }
        if (!has_next) break;
        if constexpr (Epi::ACC_INIT) { E.init(acc, nxt, wr, wc, fr, fq); } else {
#pragma unroll
        for (int a = 0; a < 2; ++a)
#pragma unroll
            for (int b = 0; b < 2; ++b)
#pragma unroll
                for (int m = 0; m < 4; ++m)
#pragma unroll
                    for (int n = 0; n < 2; ++n) acc[a][b][m][n] = (f32x4){0.f, 0.f, 0.f, 0.f}; }
        cur = nxt; cA = nA; cB = nB; ++ui;
        if constexpr (ALIGN_EPI) { if (wr == 1) PG8_BAR; }
    }
    PG8_WAIT_V(0);
    if constexpr (!ALIGN_EPI) { if (wr == 0) PG8_BAR; }
    PG8_BAR;
    if constexpr (Epi::AFTER_DRAIN) { E.fused(acc, cur, wr, wc, fr, fq, lds, wid, lane); S.done(cur); }
#undef PG8_SA
#undef PG8_SB
#undef PG8_STAGE
#undef PG8_LDA
#undef PG8_LDB
#undef PG8_MMA
#undef PG8_WAIT_V
#undef PG8_WAIT_L
#undef PG8_BAR
#undef PG8_SCHED
}
}
namespace att {
typedef unsigned short bf16;
typedef short bf16x8 __attribute__((ext_vector_type(8)));
typedef short s16x4 __attribute__((ext_vector_type(4)));
typedef float f32x16 __attribute__((ext_vector_type(16)));
typedef float f32x4 __attribute__((ext_vector_type(4)));
typedef unsigned u32x4 __attribute__((ext_vector_type(4)));
constexpr int D = 128, NW = 8, QBLK = 32, KVBLK = 64, QB = NW * QBLK, SEQ = 4096, NHEAD = 16, OPITCH = 2048;
constexpr int SHM_V = KVBLK * D * 2, SHM_K = KVBLK * D * 2;
constexpr int LDS_WS = 2 * SHM_V + 2 * SHM_K;
constexpr int LDS_CT = LDS_WS + NW * 64 * 4;
constexpr int LDS_FLAG = LDS_CT + 2 * 64 * 4;
constexpr int LDS_OST = (LDS_FLAG + 64 + 1023) / 1024 * 1024;
constexpr int LDS_BYTES = LDS_OST + NW * 4096;
#define KSWZ(row, colB) ((row) * 256 + ((colB) ^ (((row) & 7) << 4)))
#define SBAR() __builtin_amdgcn_sched_barrier(0)
__device__ __forceinline__ int v_st(int k, int c) { const int kk = (k & ~0xC) | ((k & 4) << 1) | ((k & 8) >> 1); return ((kk >> 3) * 4 + (c >> 5)) * 512 + ((kk & 7) * 32 + (c & 31)) * 2; }
__device__ __forceinline__ int v_rd_base(int lane) { return ((lane & 3) << 3) | (((lane >> 2) & 3) << 6) | (((lane >> 4) & 1) << 5) | (((lane >> 5) & 1) << 8); }
constexpr int v_rd_off(int d0, int ks, int half) { return d0 * 512 + ks * 4096 + half * 2048; }
__device__ __forceinline__ int crow(int r, int hi) { return (r & 3) + 8 * (r >> 2) + 4 * hi; }
__device__ __forceinline__ unsigned cvtpk(float lo, float hi) { unsigned r; asm volatile("v_cvt_pk_bf16_f32 %0, %1, %2" : "=v"(r) : "v"(lo), "v"(hi)); return r; }
template <int KB>
__device__ __forceinline__ void qkt(f32x16& p0, f32x16& p1, const char* K_lds, int r32, int hi, const bf16x8* qr) {
    p0 = f32x16{}; p1 = f32x16{};
    const char* kb[4];
#pragma unroll
    for (int dd = 0; dd < 4; ++dd) kb[dd] = K_lds + KB * SHM_K + KSWZ(r32, (dd * 16 + hi * 8) * 2);
#pragma unroll
    for (int d0 = 0; d0 < 8; ++d0) { const char* a = kb[d0 & 3] + (d0 >> 2) * 128;
        bf16x8 b0 = *reinterpret_cast<const bf16x8*>(a);
        bf16x8 b1 = *reinterpret_cast<const bf16x8*>(a + 32 * 256);
        p0 = __builtin_amdgcn_mfma_f32_32x32x16_bf16(b0, qr[d0], p0, 0, 0, 0);
        p1 = __builtin_amdgcn_mfma_f32_32x32x16_bf16(b1, qr[d0], p1, 0, 0, 0); }
}
template <int VB>
__device__ __forceinline__ void pv_tile(f32x16* o, int vb0, bf16x8 pa0, bf16x8 pa1, bf16x8 pa2, bf16x8 pa3) {
#define TRRD(dst, off) asm volatile("ds_read_b64_tr_b16 %0, %1 offset:%2" : "=&v"(dst) : "v"(vb0), "i"(off) : "memory")
#define PV_D0(d0) do { s16x4 l0, l1, l2, l3, h0, h1, h2, h3; constexpr int b_ = VB * SHM_V + v_rd_off(d0, 0, 0);   \
        TRRD(l0, b_); TRRD(h0, b_ + 2048); TRRD(l1, b_ + 4096); TRRD(h1, b_ + 6144); TRRD(l2, b_ + 8192); TRRD(h2, b_ + 10240); TRRD(l3, b_ + 12288); TRRD(h3, b_ + 14336); \
        asm volatile("s_waitcnt lgkmcnt(0)" ::: "memory"); SBAR();   \
        o[d0] = __builtin_amdgcn_mfma_f32_32x32x16_bf16(pa0, (bf16x8){l0[0], l0[1], l0[2], l0[3], h0[0], h0[1], h0[2], h0[3]}, o[d0], 0, 0, 0);   \
        o[d0] = __builtin_amdgcn_mfma_f32_32x32x16_bf16(pa1, (bf16x8){l1[0], l1[1], l1[2], l1[3], h1[0], h1[1], h1[2], h1[3]}, o[d0], 0, 0, 0);   \
        o[d0] = __builtin_amdgcn_mfma_f32_32x32x16_bf16(pa2, (bf16x8){l2[0], l2[1], l2[2], l2[3], h2[0], h2[1], h2[2], h2[3]}, o[d0], 0, 0, 0);   \
        o[d0] = __builtin_amdgcn_mfma_f32_32x32x16_bf16(pa3, (bf16x8){l3[0], l3[1], l3[2], l3[3], h3[0], h3[1], h3[2], h3[3]}, o[d0], 0, 0, 0); } while (0)
    PV_D0(0); PV_D0(1); PV_D0(2); PV_D0(3);
#undef PV_D0
#undef TRRD
}
__device__ __forceinline__ void pack_p(const f32x16& p0, const f32x16& p1, bf16x8& pa0, bf16x8& pa1, bf16x8& pa2, bf16x8& pa3) {
#define PK4(P, B_, OUT) do { unsigned a0 = cvtpk(P[B_+0], P[B_+1]), a1 = cvtpk(P[B_+2], P[B_+3]);                          \
        unsigned b0 = cvtpk(P[B_+4], P[B_+5]), b1 = cvtpk(P[B_+6], P[B_+7]);                                             \
        auto r0 = __builtin_amdgcn_permlane32_swap(a0, b0, false, false); auto r1 = __builtin_amdgcn_permlane32_swap(a1, b1, false, false); \
        u32x4 w = {r0[0], r1[0], r0[1], r1[1]}; OUT = *reinterpret_cast<bf16x8*>(&w); } while (0)
    PK4(p0, 0, pa0); PK4(p0, 8, pa1); PK4(p1, 0, pa2); PK4(p1, 8, pa3);
#undef PK4
}
template <bool STRICT>
__device__ __forceinline__ void mask_tile(f32x16& p0, f32x16& p1, int dq) {
    const float NEG = -__builtin_inff();
#pragma unroll
    for (int r = 0; r < 16; ++r) { const int c = (r & 3) + 8 * (r >> 2) + (STRICT ? 1 : 0);
        if (dq - c < 0) p0[r] = NEG;
        if (dq - c - 32 < 0) p1[r] = NEG; }
}
constexpr float THR2 = 8.0f * 1.4426950408889634f;

template <int MODE, int BUF>
__device__ __forceinline__ void tile_compute(f32x16 (&o)[4], float& m_reg, float& l_reg, float& R, const bf16x8* qr, const char* K_lds, int vb0, const float* ct, float* al_l,
                                             volatile __attribute__((address_space(3))) unsigned* flags, int kb, int qlo, int qm, int r32, int hi, int wid, int lane) {
    f32x16 p0, p1; bf16x8 pa0, pa1, pa2, pa3;
    qkt<BUF>(p0, p1, K_lds, r32, hi, qr);
    if (MODE == 0) {
#pragma unroll
        for (int g = 0; g < 4; ++g) { const f32x4 b0 = *(const f32x4*)(ct + BUF * 64 + 8 * g + 4 * hi), b1 = *(const f32x4*)(ct + BUF * 64 + 32 + 8 * g + 4 * hi);
#pragma unroll
            for (int i = 0; i < 4; ++i) { p0[4 * g + i] += b0[i]; p1[4 * g + i] += b1[i]; } }
        if (kb + KVBLK - 1 > qlo) mask_tile<false>(p0, p1, qm - kb);
        float pmax = p0[0];
#pragma unroll
        for (int r = 1; r < 16; ++r) pmax = fmaxf(pmax, p0[r]);
#pragma unroll
        for (int r = 0; r < 16; ++r) pmax = fmaxf(pmax, p1[r]);
        { auto rr = __builtin_amdgcn_permlane32_swap(__float_as_uint(pmax), __float_as_uint(pmax), false, false);
          pmax = fmaxf(__uint_as_float(rr[0]), __uint_as_float(rr[1])); }
        float mn, alpha;
        if (__all((pmax - m_reg) <= THR2)) { mn = m_reg; alpha = 1.f; }
        else { mn = fmaxf(m_reg, pmax); alpha = __builtin_amdgcn_exp2f(m_reg - mn); m_reg = mn; }
#pragma unroll
        for (int r = 0; r < 16; ++r) { p0[r] = __builtin_amdgcn_exp2f(p0[r] - mn); p1[r] = __builtin_amdgcn_exp2f(p1[r] - mn); }
        if (__any(alpha < 1.f)) { if (hi == 0) al_l[r32] = alpha; asm volatile("s_waitcnt lgkmcnt(0)" ::: "memory");
#pragma unroll
            for (int d_ = 0; d_ < 4; ++d_)
#pragma unroll
                for (int r = 0; r < 16; ++r) o[d_][r] *= al_l[crow(r, hi)]; }
        float ps = 0.f;
#pragma unroll
        for (int r = 0; r < 16; ++r) ps += p0[r];
#pragma unroll
        for (int r = 0; r < 16; ++r) ps += p1[r];
        { auto rr = __builtin_amdgcn_permlane32_swap(__float_as_uint(ps), __float_as_uint(ps), false, false);
          ps = __uint_as_float(rr[0]) + __uint_as_float(rr[1]); }
        l_reg = l_reg * alpha + ps;
    } else {
        if (kb + KVBLK - 1 >= qlo) mask_tile<true>(p0, p1, qm - kb);
        float t1[8], t2[8], t3[8], P[8];
#pragma unroll
        for (int r = 0; r < 16; ++r) { p0[r] = __builtin_amdgcn_rcpf(1.0f + __builtin_amdgcn_exp2f(p0[r])); p1[r] = __builtin_amdgcn_rcpf(1.0f + __builtin_amdgcn_exp2f(p1[r])); }
#pragma unroll
        for (int g = 0; g < 4; ++g) { t3[g] = p0[4 * g + 3]; t2[g] = t3[g] * p0[4 * g + 2]; t1[g] = t2[g] * p0[4 * g + 1]; P[g] = t1[g] * p0[4 * g];
            t3[g + 4] = p1[4 * g + 3]; t2[g + 4] = t3[g + 4] * p1[4 * g + 2]; t1[g + 4] = t2[g + 4] * p1[4 * g + 1]; P[g + 4] = t1[g + 4] * p1[4 * g]; }
        float E[8]; float accp = R;
#pragma unroll
        for (int g = 7; g >= 0; --g) { auto rr = __builtin_amdgcn_permlane32_swap(__float_as_uint(P[g]), __float_as_uint(P[g]), false, false);
            const float pa = __uint_as_float(rr[0]), pb = __uint_as_float(rr[1]);
            const float eb = accp; accp *= pb; const float ea = accp; accp *= pa; E[g] = hi ? eb : ea; }
        R = accp;
#pragma unroll
        for (int g = 0; g < 4; ++g) { float s3 = E[g], s2 = E[g] * t3[g], s1 = E[g] * t2[g], s0 = E[g] * t1[g];
            p0[4 * g + 3] = s3 - p0[4 * g + 3] * s3; p0[4 * g + 2] = s2 - p0[4 * g + 2] * s2; p0[4 * g + 1] = s1 - p0[4 * g + 1] * s1; p0[4 * g] = s0 - p0[4 * g] * s0;
            s3 = E[g + 4]; s2 = E[g + 4] * t3[g + 4]; s1 = E[g + 4] * t2[g + 4]; s0 = E[g + 4] * t1[g + 4];
            p1[4 * g + 3] = s3 - p1[4 * g + 3] * s3; p1[4 * g + 2] = s2 - p1[4 * g + 2] * s2; p1[4 * g + 1] = s1 - p1[4 * g + 1] * s1; p1[4 * g] = s0 - p1[4 * g] * s0; }
        const bool done = __all(R < 1e-30f);
        if (lane == 0) flags[BUF * 8 + wid] = done ? 1u : 0u;
    }
    pack_p(p0, p1, pa0, pa1, pa2, pa3);
    SBAR();
    pv_tile<BUF>(o, vb0, pa0, pa1, pa2, pa3);
}

template <int MODE>
__device__ __forceinline__ void attn_unit(int b, int h, int qb, const bf16* Q, const bf16* K, const bf16* V, bf16* O, const float* c2, float skip_thr, char* lds) {
    int tid_ = threadIdx.x; asm volatile("" : "+v"(tid_));
    const int tid = tid_, wid = __builtin_amdgcn_readfirstlane(tid >> 6), lane = tid & 63, r32 = lane & 31, hi = lane >> 5;
    const size_t hoff = (size_t)(b * NHEAD + h) * SEQ * D;
    const bf16* Qh = Q + hoff; const bf16* Kh = K + hoff; const bf16* Vh = V + hoff; const float* ch = c2 + (size_t)(b * NHEAD + h) * SEQ;
    const int q0 = qb * QB, qlo = q0 + wid * QBLK, qm = qlo + r32 - 4 * hi;
    char* V_lds = lds; char* K_lds = lds + 2 * SHM_V;
    float* ws = (float*)(lds + LDS_WS) + wid * 64; float* li_l = ws, * al_l = ws + 32;
    float* ct = (float*)(lds + LDS_CT); volatile __attribute__((address_space(3))) unsigned* flags = (volatile __attribute__((address_space(3))) unsigned*)(lds + LDS_FLAG);
    const int sr = tid >> 4, sc = (tid & 15) * 8, vst0 = v_st(sr, sc), vst1 = v_st(32 + sr, sc), kws = KSWZ(sr, sc * 2);
    const int vb0 = (int)(uintptr_t)V_lds + v_rd_base(lane);
    bf16x8 qr[8];
#pragma unroll
    for (int d0 = 0; d0 < 8; ++d0) qr[d0] = *reinterpret_cast<const bf16x8*>(Qh + (size_t)(qlo + r32) * D + d0 * 16 + hi * 8);
    float m_reg = -1e30f, l_reg = 0.f, R = 1.0f; f32x16 o[4] = {};
    const float cref = (MODE == 0) ? ch[q0] : 0.f;
    if (MODE == 1) { if (tid < 16) flags[tid] = 0u; }
    bf16x8 sk0, sk1, sv0, sv1; float sct = 0.f, cleft = 0.f;
#define ATT_LOAD(t_) do { const int kb_ = (t_) * KVBLK; sk0 = *reinterpret_cast<const bf16x8*>(Kh + (size_t)(kb_ + sr) * D + sc); sk1 = *reinterpret_cast<const bf16x8*>(Kh + (size_t)(kb_ + 32 + sr) * D + sc); \
        sv0 = *reinterpret_cast<const bf16x8*>(Vh + (size_t)(kb_ + sr) * D + sc); sv1 = *reinterpret_cast<const bf16x8*>(Vh + (size_t)(kb_ + 32 + sr) * D + sc); \
        if (MODE == 0) { if (tid < 64) sct = ch[kb_ + tid]; cleft = ch[kb_ > 0 ? kb_ - 1 : 0]; } } while (0)
#define ATT_STEP(BUF) { const int kb = t * KVBLK; \
        *(bf16x8*)(K_lds + BUF * SHM_K + kws) = sk0; *(bf16x8*)(K_lds + BUF * SHM_K + kws + 32 * 256) = sk1; *(bf16x8*)(V_lds + BUF * SHM_V + vst0) = sv0; *(bf16x8*)(V_lds + BUF * SHM_V + vst1) = sv1; \
        if (MODE == 0) { if (tid < 64) ct[BUF * 64 + tid] = cref - sct; } \
        __syncthreads();                                                       \
        if (MODE == 1) { unsigned all = 1u; _Pragma("unroll") for (int w = 0; w < 8; ++w) all &= flags[(BUF ^ 1) * 8 + w]; if (all) break; } \
        bool more = t > 0; \
        if (MODE == 0) { if (more) more = !((cref - cleft) < -skip_thr); } \
        if (more) ATT_LOAD(t - 1); \
        tile_compute<MODE, BUF>(o, m_reg, l_reg, R, qr, K_lds, vb0, ct, al_l, flags, kb, qlo, qm, r32, hi, wid, lane); \
        if (!more) break; --t; }
    int t = (q0 + QB) / KVBLK - 1;
    ATT_LOAD(t);
    for (;;) { ATT_STEP(0) ATT_STEP(1) }
#undef ATT_STEP
#undef ATT_LOAD
    float rli[16];
    if (MODE == 0) { if (hi == 0) li_l[r32] = l_reg; asm volatile("s_waitcnt lgkmcnt(0)" ::: "memory");
#pragma unroll
        for (int r = 0; r < 16; ++r) rli[r] = __builtin_amdgcn_rcpf(li_l[crow(r, hi)]); }
    else {
#pragma unroll
        for (int r = 0; r < 16; ++r) rli[r] = 1.0f; }
    bf16* Ow = O + ((size_t)b * SEQ + qlo) * OPITCH + h * D;
    char* ost = lds + LDS_OST + wid * 4096;
#pragma unroll
    for (int pass = 0; pass < 2; ++pass) {
#pragma unroll
        for (int rr = 0; rr < 8; ++rr) { const int r = pass * 8 + rr, lrow = crow(rr, hi);
#pragma unroll
            for (int d0 = 0; d0 < 4; ++d0) { const float v = o[d0][r] * rli[r]; *(unsigned short*)(ost + lrow * 256 + (d0 * 32 + r32) * 2) = (unsigned short)(cvtpk(v, v) & 0xffffu); } }
        asm volatile("s_waitcnt lgkmcnt(0)" ::: "memory");
#pragma unroll
        for (int j = 0; j < 4; ++j) { const int c = lane + 64 * j, lrow = c >> 4, c16 = c & 15; const u32x4 w = *(const u32x4*)(ost + lrow * 256 + c16 * 16);
            *(u32x4*)(Ow + (size_t)(pass * 16 + lrow) * OPITCH + c16 * 8) = w; }
        asm volatile("s_waitcnt lgkmcnt(0)" ::: "memory");
    }
    __syncthreads();
}
#undef KSWZ
#undef SBAR
}

constexpr int NWAVES = 8;
constexpr int DM = 2048, BATCH = 8, SEQ = 4096, DEPTH = 4, NH = 16, HD = 128, DFF = 5632, NFOX = 2, NSB = 2;
constexpr int M = BATCH * SEQ;
constexpr int FOXW = 3 * DM + NH;
constexpr float QK_SCALE_L2E = 0.08838834764831845f * 1.4426950408889634f;
constexpr float LOG2E = 1.4426950408889634f;

constexpr size_t MiB = 1u << 20;
constexpr size_t WS_CTL = 0, CTL_ZERO_BYTES = 1 * MiB;
constexpr size_t SZ_W1 = (size_t)2 * DFF * DM * 2, SZ_W2 = (size_t)DM * DFF * 2, SZ_WQKV = (size_t)3 * DM * DM * 2, SZ_WO = (size_t)DM * DM * 2;
constexpr size_t WS_W1 = 1 * MiB;
constexpr size_t WS_W2 = WS_W1 + 8 * SZ_W1;
constexpr size_t WS_WQKV = WS_W2 + 8 * SZ_W2;
constexpr size_t WS_WO = WS_WQKV + 4 * SZ_WQKV;
constexpr size_t WS_WF = WS_WO + 4 * SZ_WO;
constexpr size_t WS_SSQ = WS_WF + 1 * MiB;
constexpr size_t WS_RSTD = WS_SSQ + (size_t)M * 32 * 4;
constexpr size_t WS_LF = WS_RSTD + 1 * MiB;
constexpr size_t WS_C2 = WS_LF + (size_t)M * NH * 4;
constexpr size_t WS_XB = WS_C2 + (size_t)M * NH * 4;
constexpr size_t WS_Q = WS_XB + (size_t)M * DM * 2, WS_K = WS_Q + (size_t)M * DM * 2, WS_V = WS_K + (size_t)M * DM * 2;
constexpr size_t WS_O = WS_V + (size_t)M * DM * 2;
constexpr size_t WS_ACT = WS_O + (size_t)M * DM * 2;
constexpr size_t WS_END = WS_ACT + (size_t)M * DFF * 2;
constexpr int CW_BAR = 4096;

constexpr int RING_BYTES = 131072;
constexpr int PRO_WAVE_BYTES = 64 * 65 * 4;
constexpr int LDSCTL_OFF = 8 * PRO_WAVE_BYTES;
constexpr int QKTAB_OFF = LDSCTL_OFF + 256;
constexpr int RTAB_OFF = QKTAB_OFF + 8192;
constexpr int LDS_BYTES = 147456;
static_assert(LDSCTL_OFF >= RING_BYTES && RTAB_OFF + 2048 <= LDS_BYTES && att::LDS_BYTES <= RING_BYTES, "LDS map");

#define GAS __attribute__((address_space(1)))
#define LAS __attribute__((address_space(3)))
typedef unsigned short bf16;
typedef unsigned v4u __attribute__((ext_vector_type(4)));
typedef unsigned v2u __attribute__((ext_vector_type(2)));
typedef float f32x4 __attribute__((ext_vector_type(4)));
#define LDS_WAIT() asm volatile("s_waitcnt lgkmcnt(0)" ::: "memory")
__device__ __forceinline__ unsigned f2bf(float f) { unsigned u = __builtin_bit_cast(unsigned, f); return (u + 0x7fffu + ((u >> 16) & 1u)) >> 16; }
__device__ __forceinline__ unsigned pk2(float lo, float hi) { return f2bf(lo) | (f2bf(hi) << 16); }
__device__ __forceinline__ float bf2f(unsigned short v) { return __builtin_bit_cast(float, (unsigned)v << 16); }

#define XB_TMO      128
#define XB_XCNT(j)  (256  + 64 * (j))
#define XB_XSUB(j)  (1280 + 64 * (j))
#define XB_XGEN(j)  (2304 + 64 * (j))
#define XB_TOP      3328
#define XB_TOPGEN   3392
#define XCD_BAR_WORDS 3456
#define XB_SPIN_CAP (1u << 18)

__device__ __forceinline__ unsigned xb_ld(unsigned* p)              { return __hip_atomic_load(p, __ATOMIC_RELAXED, __HIP_MEMORY_SCOPE_AGENT); }
__device__ __forceinline__ unsigned xb_add(unsigned* p, unsigned v) { return __hip_atomic_fetch_add(p, v, __ATOMIC_RELAXED, __HIP_MEMORY_SCOPE_AGENT); }
__device__ __forceinline__ unsigned xb_xcc_id() { return (unsigned)__builtin_amdgcn_s_getreg((3 << 11) | 20) & 0xFu; }
#define XB_SPIN(cond, bar) do { unsigned _sp = 0; while (cond) { __builtin_amdgcn_s_sleep(1); \
    if ((++_sp & 255u) == 0u) { if (xb_ld(&(bar)[XB_TMO])) break; if (_sp > XB_SPIN_CAP) { atomicAdd(&(bar)[XB_TMO], 1u); break; } } } } while (0)

struct XcdBarrier {
    unsigned* bar; unsigned x; unsigned nmem;
    volatile LAS unsigned* st;
};

__device__ __forceinline__ XcdBarrier xcd_barrier_post(unsigned* bar, volatile LAS unsigned* st, unsigned nmem) {
    XcdBarrier b; b.bar = bar; b.x = xb_xcc_id(); b.st = st; b.nmem = nmem;
    if (threadIdx.x == 0) (void)xb_add(&bar[XB_XCNT(b.x)], 1u);
    return b;
}
__device__ __forceinline__ void xcd_barrier_complete(unsigned* bar, unsigned x, unsigned G, unsigned& nloc, unsigned& nx) {
    unsigned sum, cnt, mine, sp = 0u;
    for (;;) {
        sum = 0u; cnt = 0u; mine = 0u;
#pragma unroll
        for (unsigned j = 0; j < 16; ++j) { const unsigned c = xb_ld(&bar[XB_XCNT(j)]); sum += c; cnt += (c > 0u) ? 1u : 0u; mine = (j == x) ? c : mine; }
        if (sum == G) break;
        __builtin_amdgcn_s_sleep(1);
        if ((++sp & 255u) == 0u) { if (xb_ld(&bar[XB_TMO])) break; if (sp > XB_SPIN_CAP) { atomicAdd(&bar[XB_TMO], 1u); break; } }
    }
    nloc = mine > 0u ? mine : 1u; nx = cnt > 0u ? cnt : 1u;
}

__device__ __forceinline__ void xcd_barrier(const XcdBarrier& b) {
    asm volatile("s_waitcnt vmcnt(0)" ::: "memory");
    __syncthreads();
    if (threadIdx.x == 0) {
        unsigned* bar = b.bar;
        __builtin_amdgcn_s_waitcnt(0);
        unsigned nloc = b.st[0], nx = b.st[1];
        if (nloc == 0u) { xcd_barrier_complete(bar, b.x, b.nmem, nloc, nx); b.st[0] = nloc; b.st[1] = nx; }
        const unsigned old = xb_add(&bar[XB_XSUB(b.x)], 1u);
        const unsigned gen = old / nloc;
        if (old + 1u == (gen + 1u) * nloc) {
            __builtin_amdgcn_fence(__ATOMIC_RELEASE, "agent");
            asm volatile("s_waitcnt vmcnt(0)" ::: "memory");
            const unsigned og = xb_add(&bar[XB_TOP], 1u);
            const unsigned tg = og / nx;
            if (og + 1u == (tg + 1u) * nx) xb_add(&bar[XB_TOPGEN], 1u);
            else XB_SPIN(xb_ld(&bar[XB_TOPGEN]) == tg, bar);
            __builtin_amdgcn_fence(__ATOMIC_ACQUIRE, "agent");
            xb_add(&bar[XB_XGEN(b.x)], 1u);
            asm volatile("s_waitcnt vmcnt(0)" ::: "memory");
        } else {
            XB_SPIN(xb_ld(&bar[XB_XGEN(b.x)]) == gen, bar);
            __builtin_amdgcn_fence(__ATOMIC_ACQUIRE, "agent");
            asm volatile("s_waitcnt vmcnt(0)" ::: "memory");
        }
    }
    __syncthreads();
}

__device__ __forceinline__ float wave_sum(float v) {
#pragma unroll
    for (int o = 1; o < 64; o <<= 1) v += __shfl_xor(v, o);
    return v;
}
__device__ __forceinline__ void tr_item(const float* W, int ldw, int K, int k0, int n0, const float* g, bf16* WT, int drow0, LAS float* scr, int lane) {
#pragma unroll 4
    for (int i = 0; i < 16; ++i) { const int kk = 4 * i + (lane >> 4), c = (lane & 15) * 4;
        const f32x4 v = *(const GAS f32x4*)(W + (size_t)(k0 + kk) * ldw + n0 + c);
        LAS float* d = scr + kk * 65 + c; d[0] = v.x; d[1] = v.y; d[2] = v.z; d[3] = v.w; }
    LDS_WAIT(); asm volatile("" ::: "memory");
    const int c8 = lane & 7;
    f32x4 ga = (f32x4){1.f, 1.f, 1.f, 1.f}, gb = ga;
    if (g) { ga = *(const f32x4*)(g + k0 + 8 * c8); gb = *(const f32x4*)(g + k0 + 8 * c8 + 4); }
#pragma unroll
    for (int j = 0; j < 8; ++j) { const int n = (lane >> 3) + 8 * j; const LAS float* s = scr + (8 * c8) * 65 + n;
        v4u o; o.x = pk2(s[0 * 65] * ga.x, s[1 * 65] * ga.y); o.y = pk2(s[2 * 65] * ga.z, s[3 * 65] * ga.w); o.z = pk2(s[4 * 65] * gb.x, s[5 * 65] * gb.y); o.w = pk2(s[6 * 65] * gb.z, s[7 * 65] * gb.w);
        const int dr = drow0 + n; *(GAS v4u*)(WT + ((size_t)(dr >> 8) * (K >> 6) + (k0 >> 6)) * 16384 + (dr & 255) * 64 + 8 * c8) = o; }
    LDS_WAIT(); asm volatile("" ::: "memory");
}

#define XBAR() do { XcdBarrier b_; b_.bar = (unsigned*)(args.ws + WS_CTL) + CW_BAR + 8 * XCD_BAR_WORDS; b_.x = xb_xcc_id(); b_.nmem = (unsigned)G; b_.st = (volatile LAS unsigned*)((LAS unsigned char*)lds + LDSCTL_OFF) + 8; xcd_barrier(b_); } while (0)
#define CBAR() do { XcdBarrier b_; b_.bar = (unsigned*)(args.ws + WS_CTL) + CW_BAR + cls * XCD_BAR_WORDS; b_.x = xb_xcc_id(); b_.nmem = (unsigned)GC; b_.st = (volatile LAS unsigned*)((LAS unsigned char*)lds + LDSCTL_OFF) + 10; xcd_barrier(b_); } while (0)
struct Args {
    const float* x; const float* norm_g; const float* ffn_w_in; const float* ffn_w_out; const float* fox_w_in; const float* fox_b_f; const float* fox_qk_g; const float* sb_w_in; const float* w_o;
    float* out; unsigned char* ws;
};

__global__ void __launch_bounds__(NWAVES * 64, 2) mk_fwd(Args args) {
    extern __shared__ __attribute__((aligned(16))) unsigned char lds[];
    LAS unsigned char* ldsl = (LAS unsigned char*)lds;
    const int tid = threadIdx.x, lane = tid & 63, wave = __builtin_amdgcn_readfirstlane(tid >> 6);
    const int G = gridDim.x, bx = blockIdx.x;
    const int vcu = (G % 8 == 0) ? (bx % 8) * (G / 8) + bx / 8 : bx;
    unsigned char* ws = args.ws;
    volatile LAS unsigned* MISC = (volatile LAS unsigned*)(ldsl + LDSCTL_OFF);
    if (tid < 64) MISC[tid] = 0u;
    __syncthreads();
    const int ncls = (G % 8 == 0) ? 8 : 1, cls = bx % ncls, cj = bx / ncls, GC = G / ncls, BPC = BATCH / ncls;
    (void)xcd_barrier_post((unsigned*)(ws + WS_CTL) + CW_BAR + 8 * XCD_BAR_WORDS, MISC + 8, (unsigned)G);
    (void)xcd_barrier_post((unsigned*)(ws + WS_CTL) + CW_BAR + cls * XCD_BAR_WORDS, MISC + 10, (unsigned)GC);

    bf16* W1T = (bf16*)(ws + WS_W1); bf16* W2T = (bf16*)(ws + WS_W2); bf16* WQKVT = (bf16*)(ws + WS_WQKV); bf16* WOT = (bf16*)(ws + WS_WO);
    bf16* WFT = (bf16*)(ws + WS_WF); float* SSQ = (float*)(ws + WS_SSQ); float* RSTD = (float*)(ws + WS_RSTD); float* LF = (float*)(ws + WS_LF); float* C2 = (float*)(ws + WS_C2);
    bf16* XB = (bf16*)(ws + WS_XB); bf16* QB_ = (bf16*)(ws + WS_Q); bf16* KB_ = (bf16*)(ws + WS_K); bf16* VB_ = (bf16*)(ws + WS_V); bf16* OB = (bf16*)(ws + WS_O); bf16* ACT = (bf16*)(ws + WS_ACT);
    const int gw = vcu * NWAVES + wave, NGW = G * NWAVES;

    {
        LAS float* scr = (LAS float*)(ldsl + wave * PRO_WAVE_BYTES);
        constexpr int I_W1 = 32 * 176, I_W2 = 88 * 32, I_QKV = 32 * 96, I_WO = 32 * 32;
        constexpr int NITEMS = 8 * I_W1 + 8 * I_W2 + 4 * I_QKV + 4 * I_WO;
        for (int it = gw; it < NITEMS; it += NGW) {
            int r = it;
            if (r < 8 * I_W1) { const int mi = r / I_W1, q = r % I_W1, kb = q / 176, nb = q % 176, layer = mi >> 1, f = mi & 1;
                const int n0 = nb * 64, half = n0 / DFF, j0 = n0 % DFF, drow = 256 * (j0 / 128) + 128 * half + (j0 % 128);
                tr_item(args.ffn_w_in + (size_t)mi * DM * 2 * DFF, 2 * DFF, DM, kb * 64, n0, args.norm_g + (size_t)(layer * 3 + (f ? 2 : 0)) * DM, W1T + (size_t)mi * 2 * DFF * DM, drow, scr, lane); continue; }
            r -= 8 * I_W1;
            if (r < 8 * I_W2) { const int mi = r / I_W2, q = r % I_W2, kb = q / 32, nb = q % 32;
                tr_item(args.ffn_w_out + (size_t)mi * DFF * DM, DM, DFF, kb * 64, nb * 64, nullptr, W2T + (size_t)mi * DM * DFF, nb * 64, scr, lane); continue; }
            r -= 8 * I_W2;
            if (r < 4 * I_QKV) { const int layer = r / I_QKV, q = r % I_QKV, kb = q / 96, nb = q % 96, j = layer >> 1;
                const float* W = (layer & 1) ? args.sb_w_in + (size_t)j * DM * 3 * DM : args.fox_w_in + (size_t)j * DM * FOXW; const int ldw = (layer & 1) ? 3 * DM : FOXW;
                tr_item(W, ldw, DM, kb * 64, nb * 64, args.norm_g + (size_t)(layer * 3 + 1) * DM, WQKVT + (size_t)layer * 3 * DM * DM, nb * 64, scr, lane); continue; }
            r -= 4 * I_QKV;
            { const int layer = r / I_WO, q = r % I_WO, kb = q / 32, nb = q % 32;
                tr_item(args.w_o + (size_t)layer * DM * DM, DM, DM, kb * 64, nb * 64, nullptr, WOT + (size_t)layer * DM * DM, nb * 64, scr, lane); }
        }
        for (int i = gw * 64 + lane; i < NFOX * NH * DM; i += NGW * 64) { const int j = i / (DM * NH), h = (i / DM) % NH, k = i % DM;
            WFT[i] = (bf16)f2bf(args.norm_g[(size_t)((2 * j) * 3 + 1) * DM + k] * args.fox_w_in[(size_t)j * DM * FOXW + (size_t)k * FOXW + 3 * DM + h]); }
        for (int m = gw; m < M; m += NGW) {
            const GAS f32x4* xr = (const GAS f32x4*)(args.x + (size_t)m * DM) + lane; GAS v2u* o8 = (GAS v2u*)(XB + (size_t)m * DM) + lane; float s = 0.f;
#pragma unroll
            for (int j = 0; j < 8; ++j) { const f32x4 v = xr[64 * j]; s += (v.x * v.x + v.y * v.y) + (v.z * v.z + v.w * v.w); v2u w; w.x = pk2(v.x, v.y); w.y = pk2(v.z, v.w); o8[64 * j] = w; }
            s = wave_sum(s);
            if (lane == 0) RSTD[m] = 1.0f / sqrtf(s * (1.0f / DM) + 1e-6f);
        }
    }
    XBAR();

#define RSTD_PASS(GATE, jfox) do { int lane_o = threadIdx.x & 63; asm volatile("" : "+v"(lane_o)); const int ln = lane_o; \
        for (int tile = cj * NWAVES + wave; tile < BPC * SEQ / 16; tile += GC * NWAVES) { const int r0 = cls * BPC * SEQ + tile * 16; \
            const f32x4* p = (const f32x4*)(SSQ + (size_t)(r0 + (ln >> 2)) * 32 + (ln & 3) * 8); const f32x4 sv = p[0] + p[1]; float t = (sv[0] + sv[1]) + (sv[2] + sv[3]); \
            t += __shfl_xor(t, 1); t += __shfl_xor(t, 2); const float rs = 1.0f / sqrtf(t * (1.0f / DM) + 1e-6f); if ((ln & 3) == 0) RSTD[r0 + (ln >> 2)] = rs; \
            if (GATE) { const bf16* ap = XB + (size_t)(r0 + (ln & 15)) * DM + 8 * (ln >> 4); const bf16* bp = WFT + ((size_t)(jfox) * NH + (ln & 15)) * DM + 8 * (ln >> 4); \
                pg8::f32x4 ga = (pg8::f32x4){0.f, 0.f, 0.f, 0.f}; \
                _Pragma("unroll 8") for (int kk = 0; kk < DM / 32; ++kk) { const pg8::bf16x8 a = *(const pg8::bf16x8*)(ap + kk * 32), bq = *(const pg8::bf16x8*)(bp + kk * 32); ga = __builtin_amdgcn_mfma_f32_16x16x32_bf16(a, bq, ga, 0, 0, 0); } \
                const float bfv = args.fox_b_f[(jfox) * NH + (ln & 15)]; f32x4 o; \
                _Pragma("unroll") for (int r = 0; r < 4; ++r) { const float rr = __shfl(rs, 4 * (4 * (ln >> 4) + r)); const float v = ga[r] * rr + bfv; o[r] = fminf(v, 0.f) - log1pf(expf(-fabsf(v))); } \
                const int bb = r0 / SEQ, ss = r0 % SEQ + 4 * (ln >> 4); *(f32x4*)(LF + ((size_t)bb * NH + (ln & 15)) * SEQ + ss) = o; } } } while (0)
    for (int blk = 0; blk < 3 * DEPTH; ++blk) {
        const int layer = blk / 3, sub = blk % 3;
        const bf16* rA; const bf16* rB; int rK, rAt; float ralpha, rinv;
        if (sub != 1) {
            const int mi = layer * 2 + (sub >> 1);
            {
                pg8::Gemm g{XB, W1T + (size_t)mi * 2 * DFF * DM, M, 2 * DFF, DM, 0, 1}; pg8::RstdOrder S; S.init(M, 2 * DFF, G, bx); S.rstd = RSTD; S.tab = ldsl + RTAB_OFF;
                pg8::EpiSwiGLU E{ACT, DFF, (const PG8_LAS float*)(ldsl + RTAB_OFF)};
                pg8::gemm_phase<pg8::EpiSwiGLU, pg8::RstdOrder, true, true>(ldsl, g, S, E);
            }
            CBAR();
            rA = ACT; rB = W2T + (size_t)mi * DM * DFF; rK = DFF; rAt = 1; ralpha = 0.5f; rinv = 2.0f;
        } else {
            const int fox = !(layer & 1), j = layer >> 1;
            {
                pg8::Gemm g{XB, WQKVT + (size_t)layer * 3 * DM * DM, M, 3 * DM, DM, 0, 1}; pg8::RstdOrder S; S.init(M, 3 * DM, G, bx); S.rstd = RSTD; S.tab = ldsl + RTAB_OFF;
                pg8::EpiQKV E{QB_, (size_t)M * DM, (const PG8_LAS float*)(ldsl + RTAB_OFF), QK_SCALE_L2E, fox ? args.fox_qk_g + (size_t)j * 2 * HD : nullptr, (PG8_LAS float*)(ldsl + QKTAB_OFF)};
                pg8::gemm_phase<pg8::EpiQKV, pg8::RstdOrder, true, true>(ldsl, g, S, E);
            }
            CBAR();
            float skip_thr = 0.f;
            if (fox) {
                int lane_o = threadIdx.x & 63; asm volatile("" : "+v"(lane_o)); const int lane = lane_o;
                if (cj * NWAVES + wave < BPC * NH) { const int sq_ = cls * BPC * NH + cj * NWAVES + wave; const float* src = LF + (size_t)sq_ * SEQ + lane * 64; float* dst = C2 + (size_t)sq_ * SEQ + lane * 64;
                    float v[64]; float run = 0.f;
#pragma unroll
                    for (int i = 0; i < 16; ++i) { const f32x4 t = *(const f32x4*)(src + 4 * i); run += t.x; v[4 * i] = run; run += t.y; v[4 * i + 1] = run; run += t.z; v[4 * i + 2] = run; run += t.w; v[4 * i + 3] = run; }
                    float incl = run;
#pragma unroll
                    for (int o = 1; o < 64; o <<= 1) { const float t = __shfl_up(incl, o); if (lane >= o) incl += t; }
                    const float pre = incl - run;
#pragma unroll
                    for (int i = 0; i < 16; ++i) { f32x4 t; t.x = (v[4 * i] + pre) * LOG2E; t.y = (v[4 * i + 1] + pre) * LOG2E; t.z = (v[4 * i + 2] + pre) * LOG2E; t.w = (v[4 * i + 3] + pre) * LOG2E; *(f32x4*)(dst + 4 * i) = t; } }
                CBAR();
                const float* qkg = args.fox_qk_g + (size_t)j * 2 * HD;
                float gq = fmaxf(fabsf(qkg[lane]), fabsf(qkg[lane + 64])), gk = fmaxf(fabsf(qkg[HD + lane]), fabsf(qkg[HD + lane + 64]));
#pragma unroll
                for (int o_ = 1; o_ < 64; o_ <<= 1) { gq = fmaxf(gq, __shfl_xor(gq, o_)); gk = fmaxf(gk, __shfl_xor(gk, o_)); }
                skip_thr = (30.0f + 2.0f * 11.3137085f * 1.02f * gq * gk) * LOG2E; }
            for (int i2 = 0; ; ++i2) { const int L = (i2 >> 1) * GC + cj; if (L >= BPC * NH * 8) break;
                const int bh = cls * BPC * NH + (L >> 3), x = (i2 & 1) ? 15 - (L & 7) : (L & 7), b = bh / NH, h = bh % NH;
                if (fox) att::attn_unit<0>(b, h, x, QB_, KB_, VB_, OB, C2, skip_thr, (char*)lds);
                else     att::attn_unit<1>(b, h, x, QB_, KB_, VB_, OB, C2, 0.f, (char*)lds); }
            CBAR();
            rA = OB; rB = WOT + (size_t)layer * DM * DM; rK = DM; rAt = 0; ralpha = 1.0f; rinv = 1.0f;
        }
        {
            pg8::Gemm g{rA, rB, M, DM, rK, rAt, 1}; pg8::StaticOrder S; S.init(M, DM, G, bx, 0, 0, 4);
            pg8::EpiResid E{args.out, XB, SSQ, ralpha, rinv, DM, blk == 3 * DEPTH - 1};
            pg8::gemm_phase<pg8::EpiResid, pg8::StaticOrder, true, true>(ldsl, g, S, E);
        }
        if (blk == 3 * DEPTH - 1) break;
        CBAR();
        { const bool gate = (sub == 0) && !(layer & 1); const int jf = layer >> 1; RSTD_PASS(gate, jf); }
        CBAR();
    }
}

extern "C" void kernel_launch(void* const* d_in, const int* in_sizes, int n_in, void* d_out, int out_size, void* d_ws, size_t ws_size, hipStream_t stream) {
    static int grid = 0;
    if (grid == 0) {
        if (n_in != 9 || in_sizes[0] != M * DM || out_size != M * DM || ws_size < WS_END) { fprintf(stderr, "kernel_launch: unexpected shapes (n_in %d, in0 %d, out %d, ws %zu < %zu)\n", n_in, n_in > 0 ? in_sizes[0] : -1, out_size, ws_size, (size_t)WS_END); grid = -1; return; }
        int dev = 0, cus = 0, per_cu = 0;
        if (hipGetDevice(&dev) != hipSuccess || hipDeviceGetAttribute(&cus, hipDeviceAttributeMultiprocessorCount, dev) != hipSuccess) { grid = -1; return; }
        if (hipFuncSetAttribute((const void*)mk_fwd, hipFuncAttributeMaxDynamicSharedMemorySize, LDS_BYTES) != hipSuccess) { fprintf(stderr, "kernel_launch: hipFuncSetAttribute failed\n"); grid = -1; return; }
        if (hipOccupancyMaxActiveBlocksPerMultiprocessor(&per_cu, (const void*)mk_fwd, NWAVES * 64, LDS_BYTES) != hipSuccess || per_cu < 1) fprintf(stderr, "kernel_launch: occupancy query reports %d\n", per_cu);
        (void)hipGetLastError();
        grid = cus;
    }
    if (grid < 0) return;
    if (hipMemsetAsync((char*)d_ws + WS_CTL, 0, CTL_ZERO_BYTES, stream) != hipSuccess) return;
    Args a{};
    a.x = (const float*)d_in[0]; a.norm_g = (const float*)d_in[1]; a.ffn_w_in = (const float*)d_in[2]; a.ffn_w_out = (const float*)d_in[3]; a.fox_w_in = (const float*)d_in[4];
    a.fox_b_f = (const float*)d_in[5]; a.fox_qk_g = (const float*)d_in[6]; a.sb_w_in = (const float*)d_in[7]; a.w_o = (const float*)d_in[8];
    a.out = (float*)d_out; a.ws = (unsigned char*)d_ws;
    hipLaunchKernelGGL(mk_fwd, dim3(grid), dim3(NWAVES * 64), LDS_BYTES, stream, a);
}
```

```cpp
#include <hip/hip_runtime.h>
#include <cstdio>
#include <cstdint>
namespace pg8 {
#define PG8_LAS __attribute__((address_space(3)))
typedef unsigned short bf16_t;
typedef short bf16x8 __attribute__((ext_vector_type(8)));
typedef float f32x4 __attribute__((ext_vector_type(4)));
typedef unsigned u32x4 __attribute__((ext_vector_type(4)));
constexpr int BM = 256, BK = 64, HALF = 128, HTB = HALF * BK * 2  , STAGE_BYTES = 8 * HTB, NXCD = 8, WGM = 8;

__host__ __device__ __forceinline__ int lds_byte(int r, int c) { const int st = (r >> 4) * 2 + (c >> 5), rr = r & 15, cc = c & 31, ob = rr * 64 + cc * 2; return st * 1024 + (ob ^ (((ob >> 9) & 1) << 5)); }
__host__ __device__ __forceinline__ void stage_rc(int b, int& R, int& C) { const int st = b / 1024, sb = b % 1024, swz = sb ^ (((sb >> 9) & 1) << 5); R = (st >> 1) * 16 + swz / 64; C = (st & 1) * 32 + (swz % 64) / 2; }
__host__ __device__ __forceinline__ int perm32(int rho) { const int n = rho >> 4, i = rho & 15; return 8 * (i >> 2) + 4 * n + (i & 3); }

struct Unit { int pm, pn; };
struct Gemm { const bf16_t* A; const bf16_t* Bt; int M, N, K; int atile, btile; };

struct StaticOrder {
    int nM, nN, nwg, G, c, i0, i1, wgm;
    __host__ __device__ void init(int M, int N, int G_, int c_, int i0_ = 0, int i1_ = 0, int wgm_ = WGM) { nM = M / BM; nN = N / BM; nwg = nM * nN; G = G_; c = c_; i0 = i0_; i1 = i1_; wgm = wgm_; }
    __host__ __device__ bool next(int i, Unit& u) const {
        i += i0; if (i1 > 0 && i >= i1) return false;
        const long L = (long)i * G + c; if (L >= nwg) return false;
        int wgid = (int)L; { const int q = nwg / NXCD, r = nwg % NXCD, xcd = wgid % NXCD, off = wgid / NXCD; wgid = (xcd < r ? xcd * (q + 1) : r * (q + 1) + (xcd - r) * q) + off; }
        const int nig = wgm * nN, gid = wgid / nig, fm = gid * wgm, gsz = (nM - fm) < wgm ? (nM - fm) : wgm;
        u.pm = fm + ((wgid % nig) % gsz); u.pn = (wgid % nig) / gsz; return true;
    }
    __device__ __forceinline__ void a_ready(const Unit&) const {}
    __device__ __forceinline__ void done(const Unit&) const {}
};
struct RstdOrder : StaticOrder {
    const float* rstd; PG8_LAS unsigned char* tab;
    __device__ __forceinline__ void a_ready(const Unit& u) const {
        int t_ = threadIdx.x; asm volatile("" : "+v"(t_));
        if (__builtin_amdgcn_readfirstlane(t_ >> 6) == 0) {
            const float* src = rstd + (size_t)u.pm * BM + (t_ & 63) * 4;
            __builtin_amdgcn_global_load_lds((const unsigned*)src, (PG8_LAS unsigned*)(tab + ((u.pm >> 3) & 1) * 1024), 16, 0, 0); }
    }
};


__device__ __forceinline__ unsigned cvt_pk_bf16(float lo, float hi) { unsigned r; asm volatile("v_cvt_pk_bf16_f32 %0, %1, %2" : "=v"(r) : "v"(lo), "v"(hi)); return r; }
constexpr int SSQ_W = 32;
constexpr float RMS_EPS = 1e-6f, INV_DM = 1.0f / 2048.0f;
struct EpiSwiGLU {
    static constexpr bool PERM = true, AFTER_DRAIN = false, ACC_INIT = false;
    bf16_t* O; int ldo; const PG8_LAS float* rtab;
    __device__ __forceinline__ void operator()(const f32x4 (&acc)[2][2][4][2], const Unit& u, int wr, int wc, int fr, int fq) const {
        const int row0 = u.pm * BM + wr * 64 + fr, col0 = u.pn * HALF + wc * 32 + 8 * fq;
        float rsv[2][4];
#pragma unroll
        for (int ai = 0; ai < 2; ++ai)
#pragma unroll
            for (int m = 0; m < 4; ++m) rsv[ai][m] = rtab[((u.pm >> 3) & 1) * 256 + ai * HALF + wr * 64 + m * 16 + fr];
#pragma unroll
        for (int ai = 0; ai < 2; ++ai)
#pragma unroll
            for (int m = 0; m < 4; ++m) { const int row = row0 + ai * HALF + m * 16; const float rs = rsv[ai][m];
                const float c1 = rs * -1.4426950408889634f, rs2 = rs * rs; float ex[8], gu[8], o[8];
#pragma unroll
                for (int n = 0; n < 2; ++n)
#pragma unroll
                    for (int i = 0; i < 4; ++i) { const float g = acc[ai][0][m][n][i]; ex[n * 4 + i] = g * c1; gu[n * 4 + i] = g * acc[ai][1][m][n][i]; }
#pragma unroll
                for (int k = 0; k < 8; ++k) ex[k] = __builtin_amdgcn_exp2f(ex[k]);
#pragma unroll
                for (int k = 0; k < 8; ++k) ex[k] = 1.0f + ex[k];
#pragma unroll
                for (int k = 0; k < 8; ++k) ex[k] = __builtin_amdgcn_rcpf(ex[k]);
#pragma unroll
                for (int k = 0; k < 8; ++k) o[k] = (gu[k] * rs2) * ex[k];
                u32x4 w; w.x = cvt_pk_bf16(o[0], o[1]); w.y = cvt_pk_bf16(o[2], o[3]); w.z = cvt_pk_bf16(o[4], o[5]); w.w = cvt_pk_bf16(o[6], o[7]);
                *(u32x4*)(O + (((size_t)u.pm * (ldo / 64) + 2 * u.pn + (wc >> 1)) * BM + (row - u.pm * BM)) * 64 + (wc & 1) * 32 + 8 * fq) = w; }
    }
};
struct EpiResid {
    static constexpr bool PERM = true, AFTER_DRAIN = false, ACC_INIT = true;
    float* out; bf16_t* xh; float* ssq; float alpha, inv_alpha; int ldc; bool final_;
    __device__ __forceinline__ static f32x4 up4(unsigned a, unsigned b) { return (f32x4){__builtin_bit_cast(float, a << 16), __builtin_bit_cast(float, a & 0xffff0000u), __builtin_bit_cast(float, b << 16), __builtin_bit_cast(float, b & 0xffff0000u)}; }
    __device__ __forceinline__ void init(f32x4 (&acc)[2][2][4][2], const Unit& u, int wr, int wc, int fr, int fq) const {
        const int row0 = u.pm * BM + wr * 64 + fr, col0 = u.pn * BM + wc * 32 + 8 * fq;
#pragma unroll
        for (int ai = 0; ai < 2; ++ai)
#pragma unroll
            for (int m = 0; m < 4; ++m) { const size_t off = (size_t)(row0 + ai * HALF + m * 16) * ldc + col0;
#pragma unroll
                for (int bj = 0; bj < 2; ++bj) { const u32x4 h = *(const u32x4*)(xh + off + bj * HALF);
                    acc[ai][bj][m][0] = up4(h.x, h.y) * inv_alpha; acc[ai][bj][m][1] = up4(h.z, h.w) * inv_alpha; } }
    }
    __device__ __forceinline__ void operator()(const f32x4 (&acc)[2][2][4][2], const Unit& u, int wr, int wc, int fr, int fq) const {
        const int row0 = u.pm * BM + wr * 64 + fr, col0 = u.pn * BM + wc * 32 + 8 * fq;
        float sv[2][4];
#pragma unroll
        for (int ai = 0; ai < 2; ++ai)
#pragma unroll
            for (int m = 0; m < 4; ++m) { const int row = row0 + ai * HALF + m * 16; const size_t off = (size_t)row * ldc + col0; float s = 0.f;
#pragma unroll
                for (int bj = 0; bj < 2; ++bj) { const f32x4 o0 = acc[ai][bj][m][0] * alpha, o1 = acc[ai][bj][m][1] * alpha;
                    s += ((o0[0] * o0[0] + o0[1] * o0[1]) + (o0[2] * o0[2] + o0[3] * o0[3])) + ((o1[0] * o1[0] + o1[1] * o1[1]) + (o1[2] * o1[2] + o1[3] * o1[3]));
                    if (final_) { *(f32x4*)(out + off + bj * HALF) = o0; *(f32x4*)(out + off + bj * HALF + 4) = o1; }
                    else { u32x4 h; h.x = cvt_pk_bf16(o0[0], o0[1]); h.y = cvt_pk_bf16(o0[2], o0[3]); h.z = cvt_pk_bf16(o1[0], o1[1]); h.w = cvt_pk_bf16(o1[2], o1[3]);
                           *(u32x4*)(xh + off + bj * HALF) = h; } }
                s += __shfl_xor(s, 16); s += __shfl_xor(s, 32); sv[ai][m] = s; }
        if (!final_) {
#pragma unroll
            for (int ai = 0; ai < 2; ++ai) { const float s = fq == 0 ? sv[ai][0] : (fq == 1 ? sv[ai][1] : (fq == 2 ? sv[ai][2] : sv[ai][3]));
                ssq[(size_t)(row0 + ai * HALF + fq * 16) * SSQ_W + u.pn * 4 + wc] = s; } }
    }
};
struct EpiQKV {
    static constexpr bool PERM = true, AFTER_DRAIN = false, ACC_INIT = false;
    bf16_t* Q; size_t tstride; const PG8_LAS float* rtab; float qscale; const float* qkg; PG8_LAS float* tab;
    __device__ __forceinline__ void operator()(const f32x4 (&acc)[2][2][4][2], const Unit& u, int wr, int wc, int fr, int fq) const {
        const int which = u.pn >> 3, hp = u.pn & 7;
        bf16_t* dst = Q + (size_t)which * tstride; const float sc = which == 0 ? qscale : 1.0f;
        const int row0 = u.pm * BM + wr * 64 + fr, b = u.pm >> 4, s0 = (u.pm & 15) * BM + wr * 64 + fr, d0 = wc * 32 + 8 * fq;
        float rsv[2][4];
#pragma unroll
        for (int ai = 0; ai < 2; ++ai)
#pragma unroll
            for (int m = 0; m < 4; ++m) rsv[ai][m] = rtab[((u.pm >> 3) & 1) * 256 + ai * HALF + wr * 64 + m * 16 + fr];
        const bool norm = (qkg != nullptr) && which < 2;
        f32x4 g0 = (f32x4){1.f, 1.f, 1.f, 1.f}, g1 = g0;
        if (norm) {
            g0 = *(const f32x4*)(qkg + which * 128 + d0); g1 = *(const f32x4*)(qkg + which * 128 + d0 + 4);
#pragma unroll
            for (int ai = 0; ai < 2; ++ai)
#pragma unroll
                for (int m = 0; m < 4; ++m) { const float rs2 = rsv[ai][m] * rsv[ai][m];
#pragma unroll
                    for (int bj = 0; bj < 2; ++bj) { const f32x4 a0 = acc[ai][bj][m][0], a1 = acc[ai][bj][m][1];
                        float s = ((a0[0] * a0[0] + a0[1] * a0[1]) + (a0[2] * a0[2] + a0[3] * a0[3])) + ((a1[0] * a1[0] + a1[1] * a1[1]) + (a1[2] * a1[2] + a1[3] * a1[3]));
                        s += __shfl_xor(s, 16); s += __shfl_xor(s, 32);
                        if (fq == 0) tab[(ai * HALF + wr * 64 + m * 16 + fr) * 8 + bj * 4 + wc] = s * rs2; } }
            asm volatile("s_waitcnt lgkmcnt(0)" ::: "memory"); __builtin_amdgcn_s_barrier(); asm volatile("" ::: "memory");
        }
#pragma unroll
        for (int ai = 0; ai < 2; ++ai)
#pragma unroll
            for (int m = 0; m < 4; ++m) { const int s = s0 + ai * HALF + m * 16; const float rs = rsv[ai][m] * sc;
#pragma unroll
                for (int bj = 0; bj < 2; ++bj) { const int h = 2 * hp + bj; float rn = rs;
                    if (norm) { const f32x4 t = *(const PG8_LAS f32x4*)(tab + (ai * HALF + wr * 64 + m * 16 + fr) * 8 + bj * 4); rn = rs * __builtin_amdgcn_rsqf(((t[0] + t[1]) + (t[2] + t[3])) * (1.0f / 128.0f) + RMS_EPS); }
                    const f32x4 v0 = acc[ai][bj][m][0] * rn * g0, v1 = acc[ai][bj][m][1] * rn * g1;
                    u32x4 w; w.x = cvt_pk_bf16(v0[0], v0[1]); w.y = cvt_pk_bf16(v0[2], v0[3]); w.z = cvt_pk_bf16(v1[0], v1[1]); w.w = cvt_pk_bf16(v1[2], v1[3]);
                    *(u32x4*)(dst + ((size_t)(b * 16 + h) * 4096 + s) * 128 + d0) = w; } }
    }
};

template <class Epi, class Sched, bool ALIGN_EPI = false, bool SP2 = false>
__device__ __forceinline__ void gemm_phase(PG8_LAS unsigned char* lds, const Gemm g, const Sched& S, const Epi& E) {
    int tid_ = threadIdx.x; asm volatile("" : "+v"(tid_));
    const int tid = tid_, wid = __builtin_amdgcn_readfirstlane(tid >> 6), lane = tid & 63, wr = wid >> 2, wc = wid & 3, fr = lane & 15, fq = lane >> 4;
    const int K = g.K, nt = K / BK;
    unsigned voffA[2], voffB[2];
#pragma unroll
    for (int i = 0; i < 2; ++i) { int R, C; stage_rc(tid * 16 + i * 8192, R, C); const int Rb = Epi::PERM ? ((R & ~31) + perm32(R & 31)) : R;
        voffA[i] = (unsigned)(R * (g.atile ? BK : K) + C) * 2u; voffB[i] = (unsigned)(Rb * (g.btile ? BK : K) + C) * 2u; }
    const size_t kstepA = g.atile ? (size_t)(BM * BK * 2) : (size_t)(BK * 2), kstepB = g.btile ? (size_t)(BM * BK * 2) : (size_t)(BK * 2);
    const size_t hstepA = g.atile ? (size_t)(HALF * BK * 2) : (size_t)HALF * K * 2, hstepB = g.btile ? (size_t)(HALF * BK * 2) : (size_t)HALF * K * 2;
    const size_t tstep = (size_t)BM * K * 2;
    const unsigned ldsw = (unsigned)wid * 1024u;
    const int aoff = lds_byte(wr * 64 + fr, fq * 8), boff = lds_byte(wc * 32 + fr, fq * 8);
#define PG8_SA(b, h) (((b) * 2 + (h)) * HTB)
#define PG8_SB(b, h) ((4 + (b) * 2 + (h)) * HTB)
#define PG8_STAGE(bufoff, gbase, voff) do { _Pragma("unroll") for (int _i = 0; _i < 2; ++_i) \
        __builtin_amdgcn_global_load_lds((const unsigned*)((const char*)(gbase) + (voff)[_i]), (PG8_LAS unsigned*)(lds + (bufoff) + ldsw + _i * 8192), 16, 0, 0); } while (0)
#define PG8_LDA(dst, b, h) do { _Pragma("unroll") for (int m = 0; m < 4; ++m) _Pragma("unroll") for (int k = 0; k < 2; ++k) dst[m][k] = *(const PG8_LAS bf16x8*)(lds + PG8_SA(b, h) + aoff + m * 2048 + k * 1024); } while (0)
#define PG8_LDB(dst, b, h) do { _Pragma("unroll") for (int n = 0; n < 2; ++n) _Pragma("unroll") for (int k = 0; k < 2; ++k) dst[n][k] = *(const PG8_LAS bf16x8*)(lds + PG8_SB(b, h) + boff + n * 2048 + k * 1024); } while (0)
#define PG8_MMA(ai, bj, At, Bt) do { __builtin_amdgcn_s_setprio(1); _Pragma("unroll") for (int m = 0; m < 4; ++m) _Pragma("unroll") for (int n = 0; n < 2; ++n) _Pragma("unroll") for (int k = 0; k < 2; ++k) \
        acc[ai][bj][m][n] = __builtin_amdgcn_mfma_f32_16x16x32_bf16(Bt[n][k], At[m][k], acc[ai][bj][m][n], 0, 0, 0); __builtin_amdgcn_s_setprio(0); } while (0)
#define PG8_WAIT_V(n) asm volatile("s_waitcnt vmcnt(" #n ")" ::: "memory")
#define PG8_WAIT_L(n) asm volatile("s_waitcnt lgkmcnt(" #n ")" ::: "memory")
#define PG8_BAR __builtin_amdgcn_s_barrier()
#define PG8_SCHED __builtin_amdgcn_sched_barrier(0)
    Unit cur, nxt; int ui = 0;
    if (!S.next(0, cur)) return;
    f32x4 acc[2][2][4][2];
    if constexpr (Epi::ACC_INIT) { E.init(acc, cur, wr, wc, fr, fq); } else {
#pragma unroll
    for (int a = 0; a < 2; ++a)
#pragma unroll
        for (int b = 0; b < 2; ++b)
#pragma unroll
            for (int m = 0; m < 4; ++m)
#pragma unroll
                for (int n = 0; n < 2; ++n) acc[a][b][m][n] = (f32x4){0.f, 0.f, 0.f, 0.f}; }
    bf16x8 At[4][2], B0[2][2], B1[2][2];
    const char* cA = (const char*)g.A + (size_t)cur.pm * tstep; const char* cB = (const char*)g.Bt + (size_t)cur.pn * tstep;
    S.a_ready(cur);
    if constexpr (SP2) {
        PG8_STAGE(PG8_SB(0, 0), cB, voffB); PG8_STAGE(PG8_SB(0, 1), cB + hstepB, voffB); PG8_STAGE(PG8_SA(0, 0), cA, voffA); PG8_STAGE(PG8_SA(0, 1), cA + hstepA, voffA);
        if (wr == 1) PG8_BAR;
        PG8_WAIT_V(2); PG8_BAR;
        PG8_STAGE(PG8_SB(1, 0), cB + kstepB, voffB); PG8_STAGE(PG8_SA(1, 0), cA + kstepA, voffA); PG8_STAGE(PG8_SB(1, 1), cB + hstepB + kstepB, voffB);
        PG8_WAIT_V(6); PG8_BAR;
    } else {
        PG8_STAGE(PG8_SB(0, 0), cB, voffB); PG8_STAGE(PG8_SA(0, 0), cA, voffA); PG8_STAGE(PG8_SB(0, 1), cB + hstepB, voffB); PG8_STAGE(PG8_SA(0, 1), cA + hstepA, voffA);
        if (wr == 1) PG8_BAR;
        PG8_WAIT_V(4); PG8_BAR;
        PG8_STAGE(PG8_SB(1, 0), cB + kstepB, voffB); PG8_STAGE(PG8_SA(1, 0), cA + kstepA, voffA); PG8_STAGE(PG8_SB(1, 1), cB + hstepB + kstepB, voffB);
        PG8_WAIT_V(6); PG8_BAR;
    }
    for (;;) {
        const bool has_next = S.next(ui + 1, nxt);
        const char* nA = has_next ? (const char*)g.A + (size_t)nxt.pm * tstep : cA; const char* nB = has_next ? (const char*)g.Bt + (size_t)nxt.pn * tstep : cB;
        for (int t = 0; t < nt; t += 2) {
            const bool last = (t == nt - 2);
            const char* a1 = cA + (size_t)(t + 1) * kstepA;
            const char* a2 = last ? nA : cA + (size_t)(t + 2) * kstepA; const char* b2 = last ? nB : cB + (size_t)(t + 2) * kstepB;
            const char* a3 = a2 + kstepA; const char* b3 = b2 + kstepB;
            if (last && has_next) S.a_ready(nxt);
            if constexpr (SP2) {
            PG8_LDB(B0, 0, 0); PG8_LDB(B1, 0, 1); PG8_SCHED; PG8_LDA(At, 0, 0); PG8_STAGE(PG8_SA(1, 1), a1 + hstepA, voffA);
            PG8_WAIT_V(8); PG8_WAIT_L(0); PG8_BAR; PG8_MMA(0, 0, At, B0); PG8_MMA(0, 1, At, B1); PG8_BAR; PG8_SCHED;
            PG8_LDA(At, 0, 1); PG8_STAGE(PG8_SB(0, 0), b2, voffB); PG8_STAGE(PG8_SB(0, 1), b2 + hstepB, voffB); PG8_STAGE(PG8_SA(0, 0), a2, voffA);
            PG8_WAIT_V(8); PG8_WAIT_L(0); PG8_BAR; PG8_MMA(1, 0, At, B0); PG8_MMA(1, 1, At, B1); PG8_BAR; PG8_SCHED;
            PG8_LDB(B0, 1, 0); PG8_LDB(B1, 1, 1); PG8_SCHED; PG8_LDA(At, 1, 0); PG8_STAGE(PG8_SA(0, 1), a2 + hstepA, voffA);
            PG8_WAIT_V(8); PG8_WAIT_L(0); PG8_BAR; PG8_MMA(0, 0, At, B0); PG8_MMA(0, 1, At, B1); PG8_BAR; PG8_SCHED;
            PG8_LDA(At, 1, 1); PG8_STAGE(PG8_SB(1, 0), b3, voffB); PG8_STAGE(PG8_SB(1, 1), b3 + hstepB, voffB); PG8_STAGE(PG8_SA(1, 0), a3, voffA);
            PG8_WAIT_V(8); PG8_WAIT_L(0); PG8_BAR; PG8_MMA(1, 0, At, B0); PG8_MMA(1, 1, At, B1); PG8_BAR; PG8_SCHED;
            } else {
            PG8_LDB(B0, 0, 0); PG8_SCHED; PG8_LDA(At, 0, 0); PG8_STAGE(PG8_SA(1, 1), a1 + hstepA, voffA);
            PG8_WAIT_L(8); PG8_BAR; PG8_WAIT_L(0); PG8_MMA(0, 0, At, B0); PG8_BAR; PG8_SCHED;
            PG8_LDB(B1, 0, 1); PG8_STAGE(PG8_SB(0, 0), b2, voffB);
            PG8_BAR; PG8_WAIT_L(0); PG8_MMA(0, 1, At, B1); PG8_BAR;
            PG8_LDA(At, 0, 1); PG8_STAGE(PG8_SA(0, 0), a2, voffA);
            PG8_BAR; PG8_WAIT_L(0); PG8_MMA(1, 0, At, B0); PG8_BAR; PG8_SCHED;
            PG8_STAGE(PG8_SB(0, 1), b2 + hstepB, voffB);
            PG8_WAIT_V(6); PG8_BAR; PG8_MMA(1, 1, At, B1); PG8_BAR;
            PG8_LDB(B0, 1, 0); PG8_SCHED; PG8_LDA(At, 1, 0); PG8_STAGE(PG8_SA(0, 1), a2 + hstepA, voffA);
            PG8_WAIT_L(8); PG8_BAR; PG8_WAIT_L(0); PG8_MMA(0, 0, At, B0); PG8_BAR; PG8_SCHED;
            PG8_LDB(B1, 1, 1); PG8_STAGE(PG8_SB(1, 0), b3, voffB);
            PG8_BAR; PG8_WAIT_L(0); PG8_MMA(0, 1, At, B1); PG8_BAR;
            PG8_LDA(At, 1, 1); PG8_STAGE(PG8_SA(1, 0), a3, voffA);
            PG8_BAR; PG8_WAIT_L(0); PG8_MMA(1, 0, At, B0); PG8_BAR; PG8_SCHED;
            PG8_STAGE(PG8_SB(1, 1), b3 + hstepB, voffB);
            PG8_WAIT_V(6); PG8_BAR; PG8_MMA(1, 1, At, B1); PG8_BAR;
            }
        }
        if constexpr (ALIGN_EPI) { if (wr == 0) PG8_BAR; }
        if constexpr (!Epi::AFTER_DRAIN) { E(acc, cur, wr, wc, fr, fq); S.done(cur); }
        if (!has_next) break;
        if constexpr (Epi::ACC_INIT) { E.init(acc, nxt, wr, wc, fr, fq); } else {
#pragma unroll
        for (int a = 0; a < 2; ++a)
#pragma unroll
            for (int b = 0; b < 2; ++b)
#pragma unroll
                for (int m = 0; m < 4; ++m)
#pragma unroll
                    for (int n = 0; n < 2; ++n) acc[a][b][m][n] = (f32x4){0.f, 0.f, 0.f, 0.f}; }
        cur = nxt; cA = nA; cB = nB; ++ui;
        if constexpr (ALIGN_EPI) { if (wr == 1) PG8_BAR; }
    }
    PG8_WAIT_V(0);
    if constexpr (!ALIGN_EPI) { if (wr == 0) PG8_BAR; }
    PG8_BAR;
    if constexpr (Epi::AFTER_DRAIN) { E.fused(acc, cur, wr, wc, fr, fq, lds, wid, lane); S.done(cur); }
#undef PG8_SA
#undef PG8_SB
#undef PG8_STAGE
#undef PG8_LDA
#undef PG8_LDB
#undef PG8_MMA
#undef PG8_WAIT_V
#undef PG8_WAIT_L
#undef PG8_BAR
#undef PG8_SCHED
}
}
namespace att {
typedef unsigned short bf16;
typedef short bf16x8 __attribute__((ext_vector_type(8)));
typedef short s16x4 __attribute__((ext_vector_type(4)));
typedef float f32x16 __attribute__((ext_vector_type(16)));
typedef float f32x4 __attribute__((ext_vector_type(4)));
typedef unsigned u32x4 __attribute__((ext_vector_type(4)));
constexpr int D = 128, NW = 8, QBLK = 32, KVBLK = 64, QB = NW * QBLK, SEQ = 4096, NHEAD = 16, OPITCH = 2048;
constexpr int SHM_V = KVBLK * D * 2, SHM_K = KVBLK * D * 2;
constexpr int LDS_WS = 2 * SHM_V + 2 * SHM_K;
constexpr int LDS_CT = LDS_WS + NW * 64 * 4;
constexpr int LDS_FLAG = LDS_CT + 2 * 64 * 4;
constexpr int LDS_OST = (LDS_FLAG + 64 + 1023) / 1024 * 1024;
constexpr int LDS_BYTES = LDS_OST + NW * 4096;
#define KSWZ(row, colB) ((row) * 256 + ((colB) ^ (((row) & 7) << 4)))
#define SBAR() __builtin_amdgcn_sched_barrier(0)
__device__ __forceinline__ int v_st(int k, int c) { const int kk = (k & ~0xC) | ((k & 4) << 1) | ((k & 8) >> 1); return ((kk >> 3) * 4 + (c >> 5)) * 512 + ((kk & 7) * 32 + (c & 31)) * 2; }
__device__ __forceinline__ int v_rd_base(int lane) { return ((lane & 3) << 3) | (((lane >> 2) & 3) << 6) | (((lane >> 4) & 1) << 5) | (((lane >> 5) & 1) << 8); }
constexpr int v_rd_off(int d0, int ks, int half) { return d0 * 512 + ks * 4096 + half * 2048; }
__device__ __forceinline__ int crow(int r, int hi) { return (r & 3) + 8 * (r >> 2) + 4 * hi; }
__device__ __forceinline__ unsigned cvtpk(float lo, float hi) { unsigned r; asm volatile("v_cvt_pk_bf16_f32 %0, %1, %2" : "=v"(r) : "v"(lo), "v"(hi)); return r; }
template <int KB>
__device__ __forceinline__ void qkt(f32x16& p0, f32x16& p1, const char* K_lds, int r32, int hi, const bf16x8* qr) {
    p0 = f32x16{}; p1 = f32x16{};
    const char* kb[4];
#pragma unroll
    for (int dd = 0; dd < 4; ++dd) kb[dd] = K_lds + KB * SHM_K + KSWZ(r32, (dd * 16 + hi * 8) * 2);
#pragma unroll
    for (int d0 = 0; d0 < 8; ++d0) { const char* a = kb[d0 & 3] + (d0 >> 2) * 128;
        bf16x8 b0 = *reinterpret_cast<const bf16x8*>(a);
        bf16x8 b1 = *reinterpret_cast<const bf16x8*>(a + 32 * 256);
        p0 = __builtin_amdgcn_mfma_f32_32x32x16_bf16(b0, qr[d0], p0, 0, 0, 0);
        p1 = __builtin_amdgcn_mfma_f32_32x32x16_bf16(b1, qr[d0], p1, 0, 0, 0); }
}
template <int VB>
__device__ __forceinline__ void pv_tile(f32x16* o, int vb0, bf16x8 pa0, bf16x8 pa1, bf16x8 pa2, bf16x8 pa3) {
#define TRRD(dst, off) asm volatile("ds_read_b64_tr_b16 %0, %1 offset:%2" : "=&v"(dst) : "v"(vb0), "i"(off) : "memory")
#define PV_D0(d0) do { s16x4 l0, l1, l2, l3, h0, h1, h2, h3; constexpr int b_ = VB * SHM_V + v_rd_off(d0, 0, 0);   \
        TRRD(l0, b_); TRRD(h0, b_ + 2048); TRRD(l1, b_ + 4096); TRRD(h1, b_ + 6144); TRRD(l2, b_ + 8192); TRRD(h2, b_ + 10240); TRRD(l3, b_ + 12288); TRRD(h3, b_ + 14336); \
        asm volatile("s_waitcnt lgkmcnt(0)" ::: "memory"); SBAR();   \
        o[d0] = __builtin_amdgcn_mfma_f32_32x32x16_bf16(pa0, (bf16x8){l0[0], l0[1], l0[2], l0[3], h0[0], h0[1], h0[2], h0[3]}, o[d0], 0, 0, 0);   \
        o[d0] = __builtin_amdgcn_mfma_f32_32x32x16_bf16(pa1, (bf16x8){l1[0], l1[1], l1[2], l1[3], h1[0], h1[1], h1[2], h1[3]}, o[d0], 0, 0, 0);   \
        o[d0] = __builtin_amdgcn_mfma_f32_32x32x16_bf16(pa2, (bf16x8){l2[0], l2[1], l2[2], l2[3], h2[0], h2[1], h2[2], h2[3]}, o[d0], 0, 0, 0);   \
        o[d0] = __builtin_amdgcn_mfma_f32_32x32x16_bf16(pa3, (bf16x8){l3[0], l3[1], l3[2], l3[3], h3[0], h3[1], h3[2], h3[3]}, o[d0], 0, 0, 0); } while (0)
    PV_D0(0); PV_D0(1); PV_D0(2); PV_D0(3);
#undef PV_D0
#undef TRRD
}
__device__ __forceinline__ void pack_p(const f32x16& p0, const f32x16& p1, bf16x8& pa0, bf16x8& pa1, bf16x8& pa2, bf16x8& pa3) {
#define PK4(P, B_, OUT) do { unsigned a0 = cvtpk(P[B_+0], P[B_+1]), a1 = cvtpk(P[B_+2], P[B_+3]);                          \
        unsigned b0 = cvtpk(P[B_+4], P[B_+5]), b1 = cvtpk(P[B_+6], P[B_+7]);                                             \
        auto r0 = __builtin_amdgcn_permlane32_swap(a0, b0, false, false); auto r1 = __builtin_amdgcn_permlane32_swap(a1, b1, false, false); \
        u32x4 w = {r0[0], r1[0], r0[1], r1[1]}; OUT = *reinterpret_cast<bf16x8*>(&w); } while (0)
    PK4(p0, 0, pa0); PK4(p0, 8, pa1); PK4(p1, 0, pa2); PK4(p1, 8, pa3);
#undef PK4
}
template <bool STRICT>
__device__ __forceinline__ void mask_tile(f32x16& p0, f32x16& p1, int dq) {
    const float NEG = -__builtin_inff();
#pragma unroll
    for (int r = 0; r < 16; ++r) { const int c = (r & 3) + 8 * (r >> 2) + (STRICT ? 1 : 0);
        if (dq - c < 0) p0[r] = NEG;
        if (dq - c - 32 < 0) p1[r] = NEG; }
}
constexpr float THR2 = 8.0f * 1.4426950408889634f;

template <int MODE, int BUF>
__device__ __forceinline__ void tile_compute(f32x16 (&o)[4], float& m_reg, float& l_reg, float& R, const bf16x8* qr, const char* K_lds, int vb0, const float* ct, float* al_l,
                                             volatile __attribute__((address_space(3))) unsigned* flags, int kb, int qlo, int qm, int r32, int hi, int wid, int lane) {
    f32x16 p0, p1; bf16x8 pa0, pa1, pa2, pa3;
    qkt<BUF>(p0, p1, K_lds, r32, hi, qr);
    if (MODE == 0) {
#pragma unroll
        for (int g = 0; g < 4; ++g) { const f32x4 b0 = *(const f32x4*)(ct + BUF * 64 + 8 * g + 4 * hi), b1 = *(const f32x4*)(ct + BUF * 64 + 32 + 8 * g + 4 * hi);
#pragma unroll
            for (int i = 0; i < 4; ++i) { p0[4 * g + i] += b0[i]; p1[4 * g + i] += b1[i]; } }
        if (kb + KVBLK - 1 > qlo) mask_tile<false>(p0, p1, qm - kb);
        float pmax = p0[0];
#pragma unroll
        for (int r = 1; r < 16; ++r) pmax = fmaxf(pmax, p0[r]);
#pragma unroll
        for (int r = 0; r < 16; ++r) pmax = fmaxf(pmax, p1[r]);
        { auto rr = __builtin_amdgcn_permlane32_swap(__float_as_uint(pmax), __float_as_uint(pmax), false, false);
          pmax = fmaxf(__uint_as_float(rr[0]), __uint_as_float(rr[1])); }
        float mn, alpha;
        if (__all((pmax - m_reg) <= THR2)) { mn = m_reg; alpha = 1.f; }
        else { mn = fmaxf(m_reg, pmax); alpha = __builtin_amdgcn_exp2f(m_reg - mn); m_reg = mn; }
#pragma unroll
        for (int r = 0; r < 16; ++r) { p0[r] = __builtin_amdgcn_exp2f(p0[r] - mn); p1[r] = __builtin_amdgcn_exp2f(p1[r] - mn); }
        if (__any(alpha < 1.f)) { if (hi == 0) al_l[r32] = alpha; asm volatile("s_waitcnt lgkmcnt(0)" ::: "memory");
#pragma unroll
            for (int d_ = 0; d_ < 4; ++d_)
#pragma unroll
                for (int r = 0; r < 16; ++r) o[d_][r] *= al_l[crow(r, hi)]; }
        float ps = 0.f;
#pragma unroll
        for (int r = 0; r < 16; ++r) ps += p0[r];
#pragma unroll
        for (int r = 0; r < 16; ++r) ps += p1[r];
        { auto rr = __builtin_amdgcn_permlane32_swap(__float_as_uint(ps), __float_as_uint(ps), false, false);
          ps = __uint_as_float(rr[0]) + __uint_as_float(rr[1]); }
        l_reg = l_reg * alpha + ps;
    } else {
        if (kb + KVBLK - 1 >= qlo) mask_tile<true>(p0, p1, qm - kb);
        float t1[8], t2[8], t3[8], P[8];
#pragma unroll
        for (int r = 0; r < 16; ++r) { p0[r] = __builtin_amdgcn_rcpf(1.0f + __builtin_amdgcn_exp2f(p0[r])); p1[r] = __builtin_amdgcn_rcpf(1.0f + __builtin_amdgcn_exp2f(p1[r])); }
#pragma unroll
        for (int g = 0; g < 4; ++g) { t3[g] = p0[4 * g + 3]; t2[g] = t3[g] * p0[4 * g + 2]; t1[g] = t2[g] * p0[4 * g + 1]; P[g] = t1[g] * p0[4 * g];
            t3[g + 4] = p1[4 * g + 3]; t2[g + 4] = t3[g + 4] * p1[4 * g + 2]; t1[g + 4] = t2[g + 4] * p1[4 * g + 1]; P[g + 4] = t1[g + 4] * p1[4 * g]; }
        float E[8]; float accp = R;
#pragma unroll
        for (int g = 7; g >= 0; --g) { auto rr = __builtin_amdgcn_permlane32_swap(__float_as_uint(P[g]), __float_as_uint(P[g]), false, false);
            const float pa = __uint_as_float(rr[0]), pb = __uint_as_float(rr[1]);
            const float eb = accp; accp *= pb; const float ea = accp; accp *= pa; E[g] = hi ? eb : ea; }
        R = accp;
#pragma unroll
        for (int g = 0; g < 4; ++g) { float s3 = E[g], s2 = E[g] * t3[g], s1 = E[g] * t2[g], s0 = E[g] * t1[g];
            p0[4 * g + 3] = s3 - p0[4 * g + 3] * s3; p0[4 * g + 2] = s2 - p0[4 * g + 2] * s2; p0[4 * g + 1] = s1 - p0[4 * g + 1] * s1; p0[4 * g] = s0 - p0[4 * g] * s0;
            s3 = E[g + 4]; s2 = E[g + 4] * t3[g + 4]; s1 = E[g + 4] * t2[g + 4]; s0 = E[g + 4] * t1[g + 4];
            p1[4 * g + 3] = s3 - p1[4 * g + 3] * s3; p1[4 * g + 2] = s2 - p1[4 * g + 2] * s2; p1[4 * g + 1] = s1 - p1[4 * g + 1] * s1; p1[4 * g] = s0 - p1[4 * g] * s0; }
        const bool done = __all(R < 1e-30f);
        if (lane == 0) flags[BUF * 8 + wid] = done ? 1u : 0u;
    }
    pack_p(p0, p1, pa0, pa1, pa2, pa3);
    SBAR();
    pv_tile<BUF>(o, vb0, pa0, pa1, pa2, pa3);
}

template <int MODE>
__device__ __forceinline__ void attn_unit(int b, int h, int qb, const bf16* Q, const bf16* K, const bf16* V, bf16* O, const float* c2, float skip_thr, char* lds) {
    int tid_ = threadIdx.x; asm volatile("" : "+v"(tid_));
    const int tid = tid_, wid = __builtin_amdgcn_readfirstlane(tid >> 6), lane = tid & 63, r32 = lane & 31, hi = lane >> 5;
    const size_t hoff = (size_t)(b * NHEAD + h) * SEQ * D;
    const bf16* Qh = Q + hoff; const bf16* Kh = K + hoff; const bf16* Vh = V + hoff; const float* ch = c2 + (size_t)(b * NHEAD + h) * SEQ;
    const int q0 = qb * QB, qlo = q0 + wid * QBLK, qm = qlo + r32 - 4 * hi;
    char* V_lds = lds; char* K_lds = lds + 2 * SHM_V;
    float* ws = (float*)(lds + LDS_WS) + wid * 64; float* li_l = ws, * al_l = ws + 32;
    float* ct = (float*)(lds + LDS_CT); volatile __attribute__((address_space(3))) unsigned* flags = (volatile __attribute__((address_space(3))) unsigned*)(lds + LDS_FLAG);
    const int sr = tid >> 4, sc = (tid & 15) * 8, vst0 = v_st(sr, sc), vst1 = v_st(32 + sr, sc), kws = KSWZ(sr, sc * 2);
    const int vb0 = (int)(uintptr_t)V_lds + v_rd_base(lane);
    bf16x8 qr[8];
#pragma unroll
    for (int d0 = 0; d0 < 8; ++d0) qr[d0] = *reinterpret_cast<const bf16x8*>(Qh + (size_t)(qlo + r32) * D + d0 * 16 + hi * 8);
    float m_reg = -1e30f, l_reg = 0.f, R = 1.0f; f32x16 o[4] = {};
    const float cref = (MODE == 0) ? ch[q0] : 0.f;
    if (MODE == 1) { if (tid < 16) flags[tid] = 0u; }
    bf16x8 sk0, sk1, sv0, sv1; float sct = 0.f, cleft = 0.f;
#define ATT_LOAD(t_) do { const int kb_ = (t_) * KVBLK; sk0 = *reinterpret_cast<const bf16x8*>(Kh + (size_t)(kb_ + sr) * D + sc); sk1 = *reinterpret_cast<const bf16x8*>(Kh + (size_t)(kb_ + 32 + sr) * D + sc); \
        sv0 = *reinterpret_cast<const bf16x8*>(Vh + (size_t)(kb_ + sr) * D + sc); sv1 = *reinterpret_cast<const bf16x8*>(Vh + (size_t)(kb_ + 32 + sr) * D + sc); \
        if (MODE == 0) { if (tid < 64) sct = ch[kb_ + tid]; cleft = ch[kb_ > 0 ? kb_ - 1 : 0]; } } while (0)
#define ATT_STEP(BUF) { const int kb = t * KVBLK; \
        *(bf16x8*)(K_lds + BUF * SHM_K + kws) = sk0; *(bf16x8*)(K_lds + BUF * SHM_K + kws + 32 * 256) = sk1; *(bf16x8*)(V_lds + BUF * SHM_V + vst0) = sv0; *(bf16x8*)(V_lds + BUF * SHM_V + vst1) = sv1; \
        if (MODE == 0) { if (tid < 64) ct[BUF * 64 + tid] = cref - sct; } \
        __syncthreads();                                                       \
        if (MODE == 1) { unsigned all = 1u; _Pragma("unroll") for (int w = 0; w < 8; ++w) all &= flags[(BUF ^ 1) * 8 + w]; if (all) break; } \
        bool more = t > 0; \
        if (MODE == 0) { if (more) more = !((cref - cleft) < -skip_thr); } \
        if (more) ATT_LOAD(t - 1); \
        tile_compute<MODE, BUF>(o, m_reg, l_reg, R, qr, K_lds, vb0, ct, al_l, flags, kb, qlo, qm, r32, hi, wid, lane); \
        if (!more) break; --t; }
    int t = (q0 + QB) / KVBLK - 1;
    ATT_LOAD(t);
    for (;;) { ATT_STEP(0) ATT_STEP(1) }
#undef ATT_STEP
#undef ATT_LOAD
    float rli[16];
    if (MODE == 0) { if (hi == 0) li_l[r32] = l_reg; asm volatile("s_waitcnt lgkmcnt(0)" ::: "memory");
#pragma unroll
        for (int r = 0; r < 16; ++r) rli[r] = __builtin_amdgcn_rcpf(li_l[crow(r, hi)]); }
    else {
#pragma unroll
        for (int r = 0; r < 16; ++r) rli[r] = 1.0f; }
    bf16* Ow = O + ((size_t)b * SEQ + qlo) * OPITCH + h * D;
    char* ost = lds + LDS_OST + wid * 4096;
#pragma unroll
    for (int pass = 0; pass < 2; ++pass) {
#pragma unroll
        for (int rr = 0; rr < 8; ++rr) { const int r = pass * 8 + rr, lrow = crow(rr, hi);
#pragma unroll
            for (int d0 = 0; d0 < 4; ++d0) { const float v = o[d0][r] * rli[r]; *(unsigned short*)(ost + lrow * 256 + (d0 * 32 + r32) * 2) = (unsigned short)(cvtpk(v, v) & 0xffffu); } }
        asm volatile("s_waitcnt lgkmcnt(0)" ::: "memory");
#pragma unroll
        for (int j = 0; j < 4; ++j) { const int c = lane + 64 * j, lrow = c >> 4, c16 = c & 15; const u32x4 w = *(const u32x4*)(ost + lrow * 256 + c16 * 16);
            *(u32x4*)(Ow + (size_t)(pass * 16 + lrow) * OPITCH + c16 * 8) = w; }
        asm volatile("s_waitcnt lgkmcnt(0)" ::: "memory");
    }
    __syncthreads();
}
#undef KSWZ
#undef SBAR
}

constexpr int NWAVES = 8;
constexpr int DM = 2048, BATCH = 8, SEQ = 4096, DEPTH = 4, NH = 16, HD = 128, DFF = 5632, NFOX = 2, NSB = 2;
constexpr int M = BATCH * SEQ;
constexpr int FOXW = 3 * DM + NH;
constexpr float QK_SCALE_L2E = 0.08838834764831845f * 1.4426950408889634f;
constexpr float LOG2E = 1.4426950408889634f;

constexpr size_t MiB = 1u << 20;
constexpr size_t WS_CTL = 0, CTL_ZERO_BYTES = 1 * MiB;
constexpr size_t SZ_W1 = (size_t)2 * DFF * DM * 2, SZ_W2 = (size_t)DM * DFF * 2, SZ_WQKV = (size_t)3 * DM * DM * 2, SZ_WO = (size_t)DM * DM * 2;
constexpr size_t WS_W1 = 1 * MiB;
constexpr size_t WS_W2 = WS_W1 + 8 * SZ_W1;
constexpr size_t WS_WQKV = WS_W2 + 8 * SZ_W2;
constexpr size_t WS_WO = WS_WQKV + 4 * SZ_WQKV;
constexpr size_t WS_WF = WS_WO + 4 * SZ_WO;
constexpr size_t WS_SSQ = WS_WF + 1 * MiB;
constexpr size_t WS_RSTD = WS_SSQ + (size_t)M * 32 * 4;
constexpr size_t WS_LF = WS_RSTD + 1 * MiB;
constexpr size_t WS_C2 = WS_LF + (size_t)M * NH * 4;
constexpr size_t WS_XB = WS_C2 + (size_t)M * NH * 4;
constexpr size_t WS_Q = WS_XB + (size_t)M * DM * 2, WS_K = WS_Q + (size_t)M * DM * 2, WS_V = WS_K + (size_t)M * DM * 2;
constexpr size_t WS_O = WS_V + (size_t)M * DM * 2;
constexpr size_t WS_ACT = WS_O + (size_t)M * DM * 2;
constexpr size_t WS_END = WS_ACT + (size_t)M * DFF * 2;
constexpr int CW_BAR = 4096;

constexpr int RING_BYTES = 131072;
constexpr int PRO_WAVE_BYTES = 64 * 65 * 4;
constexpr int LDSCTL_OFF = 8 * PRO_WAVE_BYTES;
constexpr int QKTAB_OFF = LDSCTL_OFF + 256;
constexpr int RTAB_OFF = QKTAB_OFF + 8192;
constexpr int LDS_BYTES = 147456;
static_assert(LDSCTL_OFF >= RING_BYTES && RTAB_OFF + 2048 <= LDS_BYTES && att::LDS_BYTES <= RING_BYTES, "LDS map");

#define GAS __attribute__((address_space(1)))
#define LAS __attribute__((address_space(3)))
typedef unsigned short bf16;
typedef unsigned v4u __attribute__((ext_vector_type(4)));
typedef unsigned v2u __attribute__((ext_vector_type(2)));
typedef float f32x4 __attribute__((ext_vector_type(4)));
#define LDS_WAIT() asm volatile("s_waitcnt lgkmcnt(0)" ::: "memory")
__device__ __forceinline__ unsigned f2bf(float f) { unsigned u = __builtin_bit_cast(unsigned, f); return (u + 0x7fffu + ((u >> 16) & 1u)) >> 16; }
__device__ __forceinline__ unsigned pk2(float lo, float hi) { unsigned r; asm("v_cvt_pk_bf16_f32 %0, %1, %2" : "=v"(r) : "v"(lo), "v"(hi)); return r; }
__device__ __forceinline__ float bf2f(unsigned short v) { return __builtin_bit_cast(float, (unsigned)v << 16); }

#define XB_TMO      128
#define XB_XCNT(j)  (256  + 64 * (j))
#define XB_XSUB(j)  (1280 + 64 * (j))
#define XB_XGEN(j)  (2304 + 64 * (j))
#define XB_TOP      3328
#define XB_TOPGEN   3392
#define XCD_BAR_WORDS 3456
#define XB_SPIN_CAP (1u << 18)

__device__ __forceinline__ unsigned xb_ld(unsigned* p)              { return __hip_atomic_load(p, __ATOMIC_RELAXED, __HIP_MEMORY_SCOPE_AGENT); }
__device__ __forceinline__ unsigned xb_add(unsigned* p, unsigned v) { return __hip_atomic_fetch_add(p, v, __ATOMIC_RELAXED, __HIP_MEMORY_SCOPE_AGENT); }
__device__ __forceinline__ unsigned xb_xcc_id() { return (unsigned)__builtin_amdgcn_s_getreg((3 << 11) | 20) & 0xFu; }
#define XB_SPIN(cond, bar) do { unsigned _sp = 0; while (cond) { __builtin_amdgcn_s_sleep(1); \
    if ((++_sp & 255u) == 0u) { if (xb_ld(&(bar)[XB_TMO])) break; if (_sp > XB_SPIN_CAP) { atomicAdd(&(bar)[XB_TMO], 1u); break; } } } } while (0)

struct XcdBarrier {
    unsigned* bar; unsigned x; unsigned nmem;
    volatile LAS unsigned* st;
};

__device__ __forceinline__ XcdBarrier xcd_barrier_post(unsigned* bar, volatile LAS unsigned* st, unsigned nmem) {
    XcdBarrier b; b.bar = bar; b.x = xb_xcc_id(); b.st = st; b.nmem = nmem;
    if (threadIdx.x == 0) (void)xb_add(&bar[XB_XCNT(b.x)], 1u);
    return b;
}
__device__ __forceinline__ void xcd_barrier_complete(unsigned* bar, unsigned x, unsigned G, unsigned& nloc, unsigned& nx) {
    unsigned sum, cnt, mine, sp = 0u;
    for (;;) {
        sum = 0u; cnt = 0u; mine = 0u;
#pragma unroll
        for (unsigned j = 0; j < 16; ++j) { const unsigned c = xb_ld(&bar[XB_XCNT(j)]); sum += c; cnt += (c > 0u) ? 1u : 0u; mine = (j == x) ? c : mine; }
        if (sum == G) break;
        __builtin_amdgcn_s_sleep(1);
        if ((++sp & 255u) == 0u) { if (xb_ld(&bar[XB_TMO])) break; if (sp > XB_SPIN_CAP) { atomicAdd(&bar[XB_TMO], 1u); break; } }
    }
    nloc = mine > 0u ? mine : 1u; nx = cnt > 0u ? cnt : 1u;
}

__device__ __forceinline__ void xcd_barrier(const XcdBarrier& b) {
    asm volatile("s_waitcnt vmcnt(0)" ::: "memory");
    __syncthreads();
    if (threadIdx.x == 0) {
        unsigned* bar = b.bar;
        __builtin_amdgcn_s_waitcnt(0);
        unsigned nloc = b.st[0], nx = b.st[1];
        if (nloc == 0u) { xcd_barrier_complete(bar, b.x, b.nmem, nloc, nx); b.st[0] = nloc; b.st[1] = nx; }
        const unsigned old = xb_add(&bar[XB_XSUB(b.x)], 1u);
        const unsigned gen = old / nloc;
        if (old + 1u == (gen + 1u) * nloc) {
            __builtin_amdgcn_fence(__ATOMIC_RELEASE, "agent");
            asm volatile("s_waitcnt vmcnt(0)" ::: "memory");
            const unsigned og = xb_add(&bar[XB_TOP], 1u);
            const unsigned tg = og / nx;
            if (og + 1u == (tg + 1u) * nx) xb_add(&bar[XB_TOPGEN], 1u);
            else XB_SPIN(xb_ld(&bar[XB_TOPGEN]) == tg, bar);
            __builtin_amdgcn_fence(__ATOMIC_ACQUIRE, "agent");
            xb_add(&bar[XB_XGEN(b.x)], 1u);
            asm volatile("s_waitcnt vmcnt(0)" ::: "memory");
        } else {
            XB_SPIN(xb_ld(&bar[XB_XGEN(b.x)]) == gen, bar);
            __builtin_amdgcn_fence(__ATOMIC_ACQUIRE, "agent");
            asm volatile("s_waitcnt vmcnt(0)" ::: "memory");
        }
    }
    __syncthreads();
}

__device__ __forceinline__ float wave_sum(float v) {
#pragma unroll
    for (int o = 1; o < 64; o <<= 1) v += __shfl_xor(v, o);
    return v;
}
__device__ __forceinline__ void tr_item(const float* W, int ldw, int K, int k0, int n0, const float* g, bf16* WT, int drow0, LAS float* scr, int lane) {
#pragma unroll 4
    for (int i = 0; i < 16; ++i) { const int kk = 4 * i + (lane >> 4), c = (lane & 15) * 4;
        const f32x4 v = *(const GAS f32x4*)(W + (size_t)(k0 + kk) * ldw + n0 + c);
        LAS float* d = scr + kk * 65 + c; d[0] = v.x; d[1] = v.y; d[2] = v.z; d[3] = v.w; }
    LDS_WAIT(); asm volatile("" ::: "memory");
    const int c8 = lane & 7;
    f32x4 ga = (f32x4){1.f, 1.f, 1.f, 1.f}, gb = ga;
    if (g) { ga = *(const f32x4*)(g + k0 + 8 * c8); gb = *(const f32x4*)(g + k0 + 8 * c8 + 4); }
#pragma unroll
    for (int j = 0; j < 8; ++j) { const int n = (lane >> 3) + 8 * j; const LAS float* s = scr + (8 * c8) * 65 + n;
        v4u o; o.x = pk2(s[0 * 65] * ga.x, s[1 * 65] * ga.y); o.y = pk2(s[2 * 65] * ga.z, s[3 * 65] * ga.w); o.z = pk2(s[4 * 65] * gb.x, s[5 * 65] * gb.y); o.w = pk2(s[6 * 65] * gb.z, s[7 * 65] * gb.w);
        const int dr = drow0 + n; *(GAS v4u*)(WT + ((size_t)(dr >> 8) * (K >> 6) + (k0 >> 6)) * 16384 + (dr & 255) * 64 + 8 * c8) = o; }
    LDS_WAIT(); asm volatile("" ::: "memory");
}

#define XBAR() do { XcdBarrier b_; b_.bar = (unsigned*)(args.ws + WS_CTL) + CW_BAR + 8 * XCD_BAR_WORDS; b_.x = xb_xcc_id(); b_.nmem = (unsigned)G; b_.st = (volatile LAS unsigned*)((LAS unsigned char*)lds + LDSCTL_OFF) + 8; xcd_barrier(b_); } while (0)
#define CBAR() do { XcdBarrier b_; b_.bar = (unsigned*)(args.ws + WS_CTL) + CW_BAR + cls * XCD_BAR_WORDS; b_.x = xb_xcc_id(); b_.nmem = (unsigned)GC; b_.st = (volatile LAS unsigned*)((LAS unsigned char*)lds + LDSCTL_OFF) + 10; xcd_barrier(b_); } while (0)
struct Args {
    const float* x; const float* norm_g; const float* ffn_w_in; const float* ffn_w_out; const float* fox_w_in; const float* fox_b_f; const float* fox_qk_g; const float* sb_w_in; const float* w_o;
    float* out; unsigned char* ws;
};

__global__ void __launch_bounds__(NWAVES * 64, 2) mk_fwd(Args args) {
    extern __shared__ __attribute__((aligned(16))) unsigned char lds[];
    LAS unsigned char* ldsl = (LAS unsigned char*)lds;
    const int tid = threadIdx.x, lane = tid & 63, wave = __builtin_amdgcn_readfirstlane(tid >> 6);
    const int G = gridDim.x, bx = blockIdx.x;
    const int vcu = (G % 8 == 0) ? (bx % 8) * (G / 8) + bx / 8 : bx;
    unsigned char* ws = args.ws;
    volatile LAS unsigned* MISC = (volatile LAS unsigned*)(ldsl + LDSCTL_OFF);
    if (tid < 64) MISC[tid] = 0u;
    __syncthreads();
    const int ncls = (G % 8 == 0) ? 8 : 1, cls = bx % ncls, cj = bx / ncls, GC = G / ncls, BPC = BATCH / ncls;
    (void)xcd_barrier_post((unsigned*)(ws + WS_CTL) + CW_BAR + 8 * XCD_BAR_WORDS, MISC + 8, (unsigned)G);
    (void)xcd_barrier_post((unsigned*)(ws + WS_CTL) + CW_BAR + cls * XCD_BAR_WORDS, MISC + 10, (unsigned)GC);

    bf16* W1T = (bf16*)(ws + WS_W1); bf16* W2T = (bf16*)(ws + WS_W2); bf16* WQKVT = (bf16*)(ws + WS_WQKV); bf16* WOT = (bf16*)(ws + WS_WO);
    bf16* WFT = (bf16*)(ws + WS_WF); float* SSQ = (float*)(ws + WS_SSQ); float* RSTD = (float*)(ws + WS_RSTD); float* LF = (float*)(ws + WS_LF); float* C2 = (float*)(ws + WS_C2);
    bf16* XB = (bf16*)(ws + WS_XB); bf16* QB_ = (bf16*)(ws + WS_Q); bf16* KB_ = (bf16*)(ws + WS_K); bf16* VB_ = (bf16*)(ws + WS_V); bf16* OB = (bf16*)(ws + WS_O); bf16* ACT = (bf16*)(ws + WS_ACT);
    const int gw = vcu * NWAVES + wave, NGW = G * NWAVES;

    {
        LAS float* scr = (LAS float*)(ldsl + wave * PRO_WAVE_BYTES);
        constexpr int I_W1 = 32 * 176, I_W2 = 88 * 32, I_QKV = 32 * 96, I_WO = 32 * 32;
        constexpr int NITEMS = 8 * I_W1 + 8 * I_W2 + 4 * I_QKV + 4 * I_WO;
        for (int it = gw; it < NITEMS; it += NGW) {
            int r = it;
            if (r < 8 * I_W1) { const int mi = r / I_W1, q = r % I_W1, kb = q / 176, nb = q % 176, layer = mi >> 1, f = mi & 1;
                const int n0 = nb * 64, half = n0 / DFF, j0 = n0 % DFF, drow = 256 * (j0 / 128) + 128 * half + (j0 % 128);
                tr_item(args.ffn_w_in + (size_t)mi * DM * 2 * DFF, 2 * DFF, DM, kb * 64, n0, args.norm_g + (size_t)(layer * 3 + (f ? 2 : 0)) * DM, W1T + (size_t)mi * 2 * DFF * DM, drow, scr, lane); continue; }
            r -= 8 * I_W1;
            if (r < 8 * I_W2) { const int mi = r / I_W2, q = r % I_W2, kb = q / 32, nb = q % 32;
                tr_item(args.ffn_w_out + (size_t)mi * DFF * DM, DM, DFF, kb * 64, nb * 64, nullptr, W2T + (size_t)mi * DM * DFF, nb * 64, scr, lane); continue; }
            r -= 8 * I_W2;
            if (r < 4 * I_QKV) { const int layer = r / I_QKV, q = r % I_QKV, kb = q / 96, nb = q % 96, j = layer >> 1;
                const float* W = (layer & 1) ? args.sb_w_in + (size_t)j * DM * 3 * DM : args.fox_w_in + (size_t)j * DM * FOXW; const int ldw = (layer & 1) ? 3 * DM : FOXW;
                tr_item(W, ldw, DM, kb * 64, nb * 64, args.norm_g + (size_t)(layer * 3 + 1) * DM, WQKVT + (size_t)layer * 3 * DM * DM, nb * 64, scr, lane); continue; }
            r -= 4 * I_QKV;
            { const int layer = r / I_WO, q = r % I_WO, kb = q / 32, nb = q % 32;
                tr_item(args.w_o + (size_t)layer * DM * DM, DM, DM, kb * 64, nb * 64, nullptr, WOT + (size_t)layer * DM * DM, nb * 64, scr, lane); }
        }
        for (int i = gw * 64 + lane; i < NFOX * NH * DM; i += NGW * 64) { const int j = i / (DM * NH), h = (i / DM) % NH, k = i % DM;
            WFT[i] = (bf16)f2bf(args.norm_g[(size_t)((2 * j) * 3 + 1) * DM + k] * args.fox_w_in[(size_t)j * DM * FOXW + (size_t)k * FOXW + 3 * DM + h]); }
        for (int m = gw; m < M; m += NGW) {
            const GAS f32x4* xr = (const GAS f32x4*)(args.x + (size_t)m * DM) + lane; GAS v2u* o8 = (GAS v2u*)(XB + (size_t)m * DM) + lane; float s = 0.f;
#pragma unroll
            for (int j = 0; j < 8; ++j) { const f32x4 v = xr[64 * j]; s += (v.x * v.x + v.y * v.y) + (v.z * v.z + v.w * v.w); v2u w; w.x = pk2(v.x, v.y); w.y = pk2(v.z, v.w); o8[64 * j] = w; }
            s = wave_sum(s);
            if (lane == 0) RSTD[m] = 1.0f / sqrtf(s * (1.0f / DM) + 1e-6f);
        }
    }
    XBAR();

#define RSTD_PASS(GATE, jfox) do { int lane_o = threadIdx.x & 63; asm volatile("" : "+v"(lane_o)); const int ln = lane_o; \
        for (int tile = cj * NWAVES + wave; tile < BPC * SEQ / 16; tile += GC * NWAVES) { const int r0 = cls * BPC * SEQ + tile * 16; \
            const f32x4* p = (const f32x4*)(SSQ + (size_t)(r0 + (ln >> 2)) * 32 + (ln & 3) * 8); const f32x4 sv = p[0] + p[1]; float t = (sv[0] + sv[1]) + (sv[2] + sv[3]); \
            t += __shfl_xor(t, 1); t += __shfl_xor(t, 2); const float rs = 1.0f / sqrtf(t * (1.0f / DM) + 1e-6f); if ((ln & 3) == 0) RSTD[r0 + (ln >> 2)] = rs; \
            if (GATE) { const bf16* ap = XB + (size_t)(r0 + (ln & 15)) * DM + 8 * (ln >> 4); const bf16* bp = WFT + ((size_t)(jfox) * NH + (ln & 15)) * DM + 8 * (ln >> 4); \
                pg8::f32x4 ga = (pg8::f32x4){0.f, 0.f, 0.f, 0.f}; \
                _Pragma("unroll 8") for (int kk = 0; kk < DM / 32; ++kk) { const pg8::bf16x8 a = *(const pg8::bf16x8*)(ap + kk * 32), bq = *(const pg8::bf16x8*)(bp + kk * 32); ga = __builtin_amdgcn_mfma_f32_16x16x32_bf16(a, bq, ga, 0, 0, 0); } \
                const float bfv = args.fox_b_f[(jfox) * NH + (ln & 15)]; f32x4 o; \
                _Pragma("unroll") for (int r = 0; r < 4; ++r) { const float rr = __shfl(rs, 4 * (4 * (ln >> 4) + r)); const float v = ga[r] * rr + bfv; o[r] = fminf(v, 0.f) - log1pf(expf(-fabsf(v))); } \
                const int bb = r0 / SEQ, ss = r0 % SEQ + 4 * (ln >> 4); *(f32x4*)(LF + ((size_t)bb * NH + (ln & 15)) * SEQ + ss) = o; } } } while (0)
    for (int blk = 0; blk < 3 * DEPTH; ++blk) {
        const int layer = blk / 3, sub = blk % 3;
        const bf16* rA; const bf16* rB; int rK, rAt; float ralpha, rinv;
        if (sub != 1) {
            const int mi = layer * 2 + (sub >> 1);
            {
                pg8::Gemm g{XB, W1T + (size_t)mi * 2 * DFF * DM, M, 2 * DFF, DM, 0, 1}; pg8::RstdOrder S; S.init(M, 2 * DFF, G, bx); S.rstd = RSTD; S.tab = ldsl + RTAB_OFF;
                pg8::EpiSwiGLU E{ACT, DFF, (const PG8_LAS float*)(ldsl + RTAB_OFF)};
                pg8::gemm_phase<pg8::EpiSwiGLU, pg8::RstdOrder, true, true>(ldsl, g, S, E);
            }
            CBAR();
            rA = ACT; rB = W2T + (size_t)mi * DM * DFF; rK = DFF; rAt = 1; ralpha = 0.5f; rinv = 2.0f;
        } else {
            const int fox = !(layer & 1), j = layer >> 1;
            {
                pg8::Gemm g{XB, WQKVT + (size_t)layer * 3 * DM * DM, M, 3 * DM, DM, 0, 1}; pg8::RstdOrder S; S.init(M, 3 * DM, G, bx); S.rstd = RSTD; S.tab = ldsl + RTAB_OFF;
                pg8::EpiQKV E{QB_, (size_t)M * DM, (const PG8_LAS float*)(ldsl + RTAB_OFF), QK_SCALE_L2E, fox ? args.fox_qk_g + (size_t)j * 2 * HD : nullptr, (PG8_LAS float*)(ldsl + QKTAB_OFF)};
                pg8::gemm_phase<pg8::EpiQKV, pg8::RstdOrder, true, true>(ldsl, g, S, E);
            }
            CBAR();
            float skip_thr = 0.f;
            if (fox) {
                int lane_o = threadIdx.x & 63; asm volatile("" : "+v"(lane_o)); const int lane = lane_o;
                if (cj * NWAVES + wave < BPC * NH) { const int sq_ = cls * BPC * NH + cj * NWAVES + wave; const float* src = LF + (size_t)sq_ * SEQ + lane * 64; float* dst = C2 + (size_t)sq_ * SEQ + lane * 64;
                    float v[64]; float run = 0.f;
#pragma unroll
                    for (int i = 0; i < 16; ++i) { const f32x4 t = *(const f32x4*)(src + 4 * i); run += t.x; v[4 * i] = run; run += t.y; v[4 * i + 1] = run; run += t.z; v[4 * i + 2] = run; run += t.w; v[4 * i + 3] = run; }
                    float incl = run;
#pragma unroll
                    for (int o = 1; o < 64; o <<= 1) { const float t = __shfl_up(incl, o); if (lane >= o) incl += t; }
                    const float pre = incl - run;
#pragma unroll
                    for (int i = 0; i < 16; ++i) { f32x4 t; t.x = (v[4 * i] + pre) * LOG2E; t.y = (v[4 * i + 1] + pre) * LOG2E; t.z = (v[4 * i + 2] + pre) * LOG2E; t.w = (v[4 * i + 3] + pre) * LOG2E; *(f32x4*)(dst + 4 * i) = t; } }
                CBAR();
                const float* qkg = args.fox_qk_g + (size_t)j * 2 * HD;
                float gq = fmaxf(fabsf(qkg[lane]), fabsf(qkg[lane + 64])), gk = fmaxf(fabsf(qkg[HD + lane]), fabsf(qkg[HD + lane + 64]));
#pragma unroll
                for (int o_ = 1; o_ < 64; o_ <<= 1) { gq = fmaxf(gq, __shfl_xor(gq, o_)); gk = fmaxf(gk, __shfl_xor(gk, o_)); }
                skip_thr = (30.0f + 2.0f * 11.3137085f * 1.02f * gq * gk) * LOG2E; }
            for (int i2 = 0; ; ++i2) { const int L = (i2 >> 1) * GC + cj; if (L >= BPC * NH * 8) break;
                const int bh = cls * BPC * NH + (L >> 3), x = (i2 & 1) ? 15 - (L & 7) : (L & 7), b = bh / NH, h = bh % NH;
                if (fox) att::attn_unit<0>(b, h, x, QB_, KB_, VB_, OB, C2, skip_thr, (char*)lds);
                else     att::attn_unit<1>(b, h, x, QB_, KB_, VB_, OB, C2, 0.f, (char*)lds); }
            CBAR();
            rA = OB; rB = WOT + (size_t)layer * DM * DM; rK = DM; rAt = 0; ralpha = 1.0f; rinv = 1.0f;
        }
        {
            pg8::Gemm g{rA, rB, M, DM, rK, rAt, 1}; pg8::StaticOrder S; S.init(M, DM, G, bx, 0, 0, 4);
            pg8::EpiResid E{args.out, XB, SSQ, ralpha, rinv, DM, blk == 3 * DEPTH - 1};
            pg8::gemm_phase<pg8::EpiResid, pg8::StaticOrder, true, true>(ldsl, g, S, E);
        }
        if (blk == 3 * DEPTH - 1) break;
        CBAR();
        { const bool gate = (sub == 0) && !(layer & 1); const int jf = layer >> 1; RSTD_PASS(gate, jf); }
        CBAR();
    }
}

extern "C" void kernel_launch(void* const* d_in, const int* in_sizes, int n_in, void* d_out, int out_size, void* d_ws, size_t ws_size, hipStream_t stream) {
    static int grid = 0;
    if (grid == 0) {
        if (n_in != 9 || in_sizes[0] != M * DM || out_size != M * DM || ws_size < WS_END) { fprintf(stderr, "kernel_launch: unexpected shapes (n_in %d, in0 %d, out %d, ws %zu < %zu)\n", n_in, n_in > 0 ? in_sizes[0] : -1, out_size, ws_size, (size_t)WS_END); grid = -1; return; }
        int dev = 0, cus = 0, per_cu = 0;
        if (hipGetDevice(&dev) != hipSuccess || hipDeviceGetAttribute(&cus, hipDeviceAttributeMultiprocessorCount, dev) != hipSuccess) { grid = -1; return; }
        if (hipFuncSetAttribute((const void*)mk_fwd, hipFuncAttributeMaxDynamicSharedMemorySize, LDS_BYTES) != hipSuccess) { fprintf(stderr, "kernel_launch: hipFuncSetAttribute failed\n"); grid = -1; return; }
        if (hipOccupancyMaxActiveBlocksPerMultiprocessor(&per_cu, (const void*)mk_fwd, NWAVES * 64, LDS_BYTES) != hipSuccess || per_cu < 1) fprintf(stderr, "kernel_launch: occupancy query reports %d\n", per_cu);
        (void)hipGetLastError();
        grid = cus;
    }
    if (grid < 0) return;
    if (hipMemsetAsync((char*)d_ws + WS_CTL, 0, CTL_ZERO_BYTES, stream) != hipSuccess) return;
    Args a{};
    a.x = (const float*)d_in[0]; a.norm_g = (const float*)d_in[1]; a.ffn_w_in = (const float*)d_in[2]; a.ffn_w_out = (const float*)d_in[3]; a.fox_w_in = (const float*)d_in[4];
    a.fox_b_f = (const float*)d_in[5]; a.fox_qk_g = (const float*)d_in[6]; a.sb_w_in = (const float*)d_in[7]; a.w_o = (const float*)d_in[8];
    a.out = (float*)d_out; a.ws = (unsigned char*)d_ws;
    hipLaunchKernelGGL(mk_fwd, dim3(grid), dim3(NWAVES * 64), LDS_BYTES, stream, a);
}
```

```cpp
#include <hip/hip_runtime.h>
#include <cstdio>
#include <cstdint>
namespace pg8 {
#define PG8_LAS __attribute__((address_space(3)))
typedef unsigned short bf16_t;
typedef short bf16x8 __attribute__((ext_vector_type(8)));
typedef float f32x4 __attribute__((ext_vector_type(4)));
typedef unsigned u32x4 __attribute__((ext_vector_type(4)));
constexpr int BM = 256, BK = 64, HALF = 128, HTB = HALF * BK * 2  , STAGE_BYTES = 8 * HTB, NXCD = 8, WGM = 8;

__host__ __device__ __forceinline__ int lds_byte(int r, int c) { const int st = (r >> 4) * 2 + (c >> 5), rr = r & 15, cc = c & 31, ob = rr * 64 + cc * 2; return st * 1024 + (ob ^ (((ob >> 9) & 1) << 5)); }
__host__ __device__ __forceinline__ void stage_rc(int b, int& R, int& C) { const int st = b / 1024, sb = b % 1024, swz = sb ^ (((sb >> 9) & 1) << 5); R = (st >> 1) * 16 + swz / 64; C = (st & 1) * 32 + (swz % 64) / 2; }
__host__ __device__ __forceinline__ int perm32(int rho) { const int n = rho >> 4, i = rho & 15; return 8 * (i >> 2) + 4 * n + (i & 3); }

struct Unit { int pm, pn; };
struct Gemm { const bf16_t* A; const bf16_t* Bt; int M, N, K; int atile, btile; };

struct StaticOrder {
    int nM, nN, nwg, G, c, i0, i1, wgm;
    __host__ __device__ void init(int M, int N, int G_, int c_, int i0_ = 0, int i1_ = 0, int wgm_ = WGM) { nM = M / BM; nN = N / BM; nwg = nM * nN; G = G_; c = c_; i0 = i0_; i1 = i1_; wgm = wgm_; }
    __host__ __device__ bool next(int i, Unit& u) const {
        i += i0; if (i1 > 0 && i >= i1) return false;
        const long L = (long)i * G + c; if (L >= nwg) return false;
        int wgid = (int)L; { const int q = nwg / NXCD, r = nwg % NXCD, xcd = wgid % NXCD, off = wgid / NXCD; wgid = (xcd < r ? xcd * (q + 1) : r * (q + 1) + (xcd - r) * q) + off; }
        const int nig = wgm * nN, gid = wgid / nig, fm = gid * wgm, gsz = (nM - fm) < wgm ? (nM - fm) : wgm;
        u.pm = fm + ((wgid % nig) % gsz); u.pn = (wgid % nig) / gsz; return true;
    }
    __device__ __forceinline__ void a_ready(const Unit&) const {}
    __device__ __forceinline__ void done(const Unit&) const {}
};
struct RstdOrder : StaticOrder {
    const float* rstd; PG8_LAS unsigned char* tab;
    __device__ __forceinline__ void a_ready(const Unit& u) const {
        int t_ = threadIdx.x; asm volatile("" : "+v"(t_));
        if (__builtin_amdgcn_readfirstlane(t_ >> 6) == 0) {
            const float* src = rstd + (size_t)u.pm * BM + (t_ & 63) * 4;
            __builtin_amdgcn_global_load_lds((const unsigned*)src, (PG8_LAS unsigned*)(tab + ((u.pm >> 3) & 1) * 1024), 16, 0, 0); }
    }
};


__device__ __forceinline__ unsigned cvt_pk_bf16(float lo, float hi) { unsigned r; asm volatile("v_cvt_pk_bf16_f32 %0, %1, %2" : "=v"(r) : "v"(lo), "v"(hi)); return r; }
constexpr int SSQ_W = 32;
constexpr float RMS_EPS = 1e-6f, INV_DM = 1.0f / 2048.0f;
struct EpiSwiGLU {
    static constexpr bool PERM = true, AFTER_DRAIN = false, ACC_INIT = false;
    bf16_t* O; int ldo; const PG8_LAS float* rtab;
    __device__ __forceinline__ void operator()(const f32x4 (&acc)[2][2][4][2], const Unit& u, int wr, int wc, int fr, int fq) const {
        const int row0 = u.pm * BM + wr * 64 + fr, col0 = u.pn * HALF + wc * 32 + 8 * fq;
        float rsv[2][4];
#pragma unroll
        for (int ai = 0; ai < 2; ++ai)
#pragma unroll
            for (int m = 0; m < 4; ++m) rsv[ai][m] = rtab[((u.pm >> 3) & 1) * 256 + ai * HALF + wr * 64 + m * 16 + fr];
#pragma unroll
        for (int ai = 0; ai < 2; ++ai)
#pragma unroll
            for (int m = 0; m < 4; ++m) { const int row = row0 + ai * HALF + m * 16; const float rs = rsv[ai][m];
                const float c1 = rs * -1.4426950408889634f, rs2 = rs * rs; float ex[8], gu[8], o[8];
#pragma unroll
                for (int n = 0; n < 2; ++n)
#pragma unroll
                    for (int i = 0; i < 4; ++i) { const float g = acc[ai][0][m][n][i]; ex[n * 4 + i] = g * c1; gu[n * 4 + i] = g * acc[ai][1][m][n][i]; }
#pragma unroll
                for (int k = 0; k < 8; ++k) ex[k] = __builtin_amdgcn_exp2f(ex[k]);
#pragma unroll
                for (int k = 0; k < 8; ++k) ex[k] = 1.0f + ex[k];
#pragma unroll
                for (int k = 0; k < 8; ++k) ex[k] = __builtin_amdgcn_rcpf(ex[k]);
#pragma unroll
                for (int k = 0; k < 8; ++k) o[k] = (gu[k] * rs2) * ex[k];
                u32x4 w; w.x = cvt_pk_bf16(o[0], o[1]); w.y = cvt_pk_bf16(o[2], o[3]); w.z = cvt_pk_bf16(o[4], o[5]); w.w = cvt_pk_bf16(o[6], o[7]);
                *(u32x4*)(O + (((size_t)u.pm * (ldo / 64) + 2 * u.pn + (wc >> 1)) * BM + (row - u.pm * BM)) * 64 + (wc & 1) * 32 + 8 * fq) = w; }
    }
};
struct EpiResid {
    static constexpr bool PERM = true, AFTER_DRAIN = false, ACC_INIT = true;
    float* out; bf16_t* xh; float* ssq; float alpha, inv_alpha; int ldc; bool final_;
    __device__ __forceinline__ static f32x4 up4(unsigned a, unsigned b) { return (f32x4){__builtin_bit_cast(float, a << 16), __builtin_bit_cast(float, a & 0xffff0000u), __builtin_bit_cast(float, b << 16), __builtin_bit_cast(float, b & 0xffff0000u)}; }
    __device__ __forceinline__ void init(f32x4 (&acc)[2][2][4][2], const Unit& u, int wr, int wc, int fr, int fq) const {
        const int row0 = u.pm * BM + wr * 64 + fr, col0 = u.pn * BM + wc * 32 + 8 * fq;
#pragma unroll
        for (int ai = 0; ai < 2; ++ai)
#pragma unroll
            for (int m = 0; m < 4; ++m) { const size_t off = (size_t)(row0 + ai * HALF + m * 16) * ldc + col0;
#pragma unroll
                for (int bj = 0; bj < 2; ++bj) { const u32x4 h = *(const u32x4*)(xh + off + bj * HALF);
                    acc[ai][bj][m][0] = up4(h.x, h.y) * inv_alpha; acc[ai][bj][m][1] = up4(h.z, h.w) * inv_alpha; } }
    }
    __device__ __forceinline__ void operator()(const f32x4 (&acc)[2][2][4][2], const Unit& u, int wr, int wc, int fr, int fq) const {
        const int row0 = u.pm * BM + wr * 64 + fr, col0 = u.pn * BM + wc * 32 + 8 * fq;
        float sv[2][4];
#pragma unroll
        for (int ai = 0; ai < 2; ++ai)
#pragma unroll
            for (int m = 0; m < 4; ++m) { const int row = row0 + ai * HALF + m * 16; const size_t off = (size_t)row * ldc + col0; float s = 0.f;
#pragma unroll
                for (int bj = 0; bj < 2; ++bj) { const f32x4 o0 = acc[ai][bj][m][0] * alpha, o1 = acc[ai][bj][m][1] * alpha;
                    s += ((o0[0] * o0[0] + o0[1] * o0[1]) + (o0[2] * o0[2] + o0[3] * o0[3])) + ((o1[0] * o1[0] + o1[1] * o1[1]) + (o1[2] * o1[2] + o1[3] * o1[3]));
                    if (final_) { *(f32x4*)(out + off + bj * HALF) = o0; *(f32x4*)(out + off + bj * HALF + 4) = o1; }
                    else { u32x4 h; h.x = cvt_pk_bf16(o0[0], o0[1]); h.y = cvt_pk_bf16(o0[2], o0[3]); h.z = cvt_pk_bf16(o1[0], o1[1]); h.w = cvt_pk_bf16(o1[2], o1[3]);
                           *(u32x4*)(xh + off + bj * HALF) = h; } }
                s += __shfl_xor(s, 16); s += __shfl_xor(s, 32); sv[ai][m] = s; }
        if (!final_) {
#pragma unroll
            for (int ai = 0; ai < 2; ++ai) { const float s = fq == 0 ? sv[ai][0] : (fq == 1 ? sv[ai][1] : (fq == 2 ? sv[ai][2] : sv[ai][3]));
                ssq[(size_t)(row0 + ai * HALF + fq * 16) * SSQ_W + u.pn * 4 + wc] = s; } }
    }
};
struct EpiQKV {
    static constexpr bool PERM = true, AFTER_DRAIN = false, ACC_INIT = false;
    bf16_t* Q; size_t tstride; const PG8_LAS float* rtab; float qscale; const float* qkg; PG8_LAS float* tab;
    __device__ __forceinline__ void operator()(const f32x4 (&acc)[2][2][4][2], const Unit& u, int wr, int wc, int fr, int fq) const {
        const int which = u.pn >> 3, hp = u.pn & 7;
        bf16_t* dst = Q + (size_t)which * tstride; const float sc = which == 0 ? qscale : 1.0f;
        const int row0 = u.pm * BM + wr * 64 + fr, b = u.pm >> 4, s0 = (u.pm & 15) * BM + wr * 64 + fr, d0 = wc * 32 + 8 * fq;
        float rsv[2][4];
#pragma unroll
        for (int ai = 0; ai < 2; ++ai)
#pragma unroll
            for (int m = 0; m < 4; ++m) rsv[ai][m] = rtab[((u.pm >> 3) & 1) * 256 + ai * HALF + wr * 64 + m * 16 + fr];
        const bool norm = (qkg != nullptr) && which < 2;
        f32x4 g0 = (f32x4){1.f, 1.f, 1.f, 1.f}, g1 = g0;
        if (norm) {
            g0 = *(const f32x4*)(qkg + which * 128 + d0); g1 = *(const f32x4*)(qkg + which * 128 + d0 + 4);
#pragma unroll
            for (int ai = 0; ai < 2; ++ai)
#pragma unroll
                for (int m = 0; m < 4; ++m) { const float rs2 = rsv[ai][m] * rsv[ai][m];
#pragma unroll
                    for (int bj = 0; bj < 2; ++bj) { const f32x4 a0 = acc[ai][bj][m][0], a1 = acc[ai][bj][m][1];
                        float s = ((a0[0] * a0[0] + a0[1] * a0[1]) + (a0[2] * a0[2] + a0[3] * a0[3])) + ((a1[0] * a1[0] + a1[1] * a1[1]) + (a1[2] * a1[2] + a1[3] * a1[3]));
                        s += __shfl_xor(s, 16); s += __shfl_xor(s, 32);
                        if (fq == 0) tab[(ai * HALF + wr * 64 + m * 16 + fr) * 8 + bj * 4 + wc] = s * rs2; } }
            asm volatile("s_waitcnt lgkmcnt(0)" ::: "memory"); __builtin_amdgcn_s_barrier(); asm volatile("" ::: "memory");
        }
#pragma unroll
        for (int ai = 0; ai < 2; ++ai)
#pragma unroll
            for (int m = 0; m < 4; ++m) { const int s = s0 + ai * HALF + m * 16; const float rs = rsv[ai][m] * sc;
#pragma unroll
                for (int bj = 0; bj < 2; ++bj) { const int h = 2 * hp + bj; float rn = rs;
                    if (norm) { const f32x4 t = *(const PG8_LAS f32x4*)(tab + (ai * HALF + wr * 64 + m * 16 + fr) * 8 + bj * 4); rn = rs * __builtin_amdgcn_rsqf(((t[0] + t[1]) + (t[2] + t[3])) * (1.0f / 128.0f) + RMS_EPS); }
                    const f32x4 v0 = acc[ai][bj][m][0] * rn * g0, v1 = acc[ai][bj][m][1] * rn * g1;
                    u32x4 w; w.x = cvt_pk_bf16(v0[0], v0[1]); w.y = cvt_pk_bf16(v0[2], v0[3]); w.z = cvt_pk_bf16(v1[0], v1[1]); w.w = cvt_pk_bf16(v1[2], v1[3]);
                    *(u32x4*)(dst + ((size_t)(b * 16 + h) * 4096 + s) * 128 + d0) = w; } }
    }
};

template <class Epi, class Sched, bool ALIGN_EPI = false, bool SP2 = false>
__device__ __forceinline__ void gemm_phase(PG8_LAS unsigned char* lds, const Gemm g, const Sched& S, const Epi& E) {
    int tid_ = threadIdx.x; asm volatile("" : "+v"(tid_));
    const int tid = tid_, wid = __builtin_amdgcn_readfirstlane(tid >> 6), lane = tid & 63, wr = wid >> 2, wc = wid & 3, fr = lane & 15, fq = lane >> 4;
    const int K = g.K, nt = K / BK;
    unsigned voffA[2], voffB[2];
#pragma unroll
    for (int i = 0; i < 2; ++i) { int R, C; stage_rc(tid * 16 + i * 8192, R, C); const int Rb = Epi::PERM ? ((R & ~31) + perm32(R & 31)) : R;
        voffA[i] = (unsigned)(R * (g.atile ? BK : K) + C) * 2u; voffB[i] = (unsigned)(Rb * (g.btile ? BK : K) + C) * 2u; }
    const size_t kstepA = g.atile ? (size_t)(BM * BK * 2) : (size_t)(BK * 2), kstepB = g.btile ? (size_t)(BM * BK * 2) : (size_t)(BK * 2);
    const size_t hstepA = g.atile ? (size_t)(HALF * BK * 2) : (size_t)HALF * K * 2, hstepB = g.btile ? (size_t)(HALF * BK * 2) : (size_t)HALF * K * 2;
    const size_t tstep = (size_t)BM * K * 2;
    const unsigned ldsw = (unsigned)wid * 1024u;
    const int aoff = lds_byte(wr * 64 + fr, fq * 8), boff = lds_byte(wc * 32 + fr, fq * 8);
#define PG8_SA(b, h) (((b) * 2 + (h)) * HTB)
#define PG8_SB(b, h) ((4 + (b) * 2 + (h)) * HTB)
#define PG8_STAGE(bufoff, gbase, voff) do { _Pragma("unroll") for (int _i = 0; _i < 2; ++_i) \
        __builtin_amdgcn_global_load_lds((const unsigned*)((const char*)(gbase) + (voff)[_i]), (PG8_LAS unsigned*)(lds + (bufoff) + ldsw + _i * 8192), 16, 0, 0); } while (0)
#define PG8_LDA(dst, b, h) do { _Pragma("unroll") for (int m = 0; m < 4; ++m) _Pragma("unroll") for (int k = 0; k < 2; ++k) dst[m][k] = *(const PG8_LAS bf16x8*)(lds + PG8_SA(b, h) + aoff + m * 2048 + k * 1024); } while (0)
#define PG8_LDB(dst, b, h) do { _Pragma("unroll") for (int n = 0; n < 2; ++n) _Pragma("unroll") for (int k = 0; k < 2; ++k) dst[n][k] = *(const PG8_LAS bf16x8*)(lds + PG8_SB(b, h) + boff + n * 2048 + k * 1024); } while (0)
#define PG8_MMA(ai, bj, At, Bt) do { __builtin_amdgcn_s_setprio(1); _Pragma("unroll") for (int m = 0; m < 4; ++m) _Pragma("unroll") for (int n = 0; n < 2; ++n) _Pragma("unroll") for (int k = 0; k < 2; ++k) \
        acc[ai][bj][m][n] = __builtin_amdgcn_mfma_f32_16x16x32_bf16(Bt[n][k], At[m][k], acc[ai][bj][m][n], 0, 0, 0); __builtin_amdgcn_s_setprio(0); } while (0)
#define PG8_WAIT_V(n) asm volatile("s_waitcnt vmcnt(" #n ")" ::: "memory")
#define PG8_WAIT_L(n) asm volatile("s_waitcnt lgkmcnt(" #n ")" ::: "memory")
#define PG8_BAR __builtin_amdgcn_s_barrier()
#define PG8_SCHED __builtin_amdgcn_sched_barrier(0)
    Unit cur, nxt; int ui = 0;
    if (!S.next(0, cur)) return;
    f32x4 acc[2][2][4][2];
    if constexpr (Epi::ACC_INIT) { E.init(acc, cur, wr, wc, fr, fq); } else {
#pragma unroll
    for (int a = 0; a < 2; ++a)
#pragma unroll
        for (int b = 0; b < 2; ++b)
#pragma unroll
            for (int m = 0; m < 4; ++m)
#pragma unroll
                for (int n = 0; n < 2; ++n) acc[a][b][m][n] = (f32x4){0.f, 0.f, 0.f, 0.f}; }
    bf16x8 At[4][2], B0[2][2], B1[2][2];
    const char* cA = (const char*)g.A + (size_t)cur.pm * tstep; const char* cB = (const char*)g.Bt + (size_t)cur.pn * tstep;
    S.a_ready(cur);
    if constexpr (SP2) {
        PG8_STAGE(PG8_SB(0, 0), cB, voffB); PG8_STAGE(PG8_SB(0, 1), cB + hstepB, voffB); PG8_STAGE(PG8_SA(0, 0), cA, voffA); PG8_STAGE(PG8_SA(0, 1), cA + hstepA, voffA);
        if (wr == 1) PG8_BAR;
        PG8_WAIT_V(2); PG8_BAR;
        PG8_STAGE(PG8_SB(1, 0), cB + kstepB, voffB); PG8_STAGE(PG8_SA(1, 0), cA + kstepA, voffA); PG8_STAGE(PG8_SB(1, 1), cB + hstepB + kstepB, voffB);
        PG8_WAIT_V(6); PG8_BAR;
    } else {
        PG8_STAGE(PG8_SB(0, 0), cB, voffB); PG8_STAGE(PG8_SA(0, 0), cA, voffA); PG8_STAGE(PG8_SB(0, 1), cB + hstepB, voffB); PG8_STAGE(PG8_SA(0, 1), cA + hstepA, voffA);
        if (wr == 1) PG8_BAR;
        PG8_WAIT_V(4); PG8_BAR;
        PG8_STAGE(PG8_SB(1, 0), cB + kstepB, voffB); PG8_STAGE(PG8_SA(1, 0), cA + kstepA, voffA); PG8_STAGE(PG8_SB(1, 1), cB + hstepB + kstepB, voffB);
        PG8_WAIT_V(6); PG8_BAR;
    }
    for (;;) {
        const bool has_next = S.next(ui + 1, nxt);
        const char* nA = has_next ? (const char*)g.A + (size_t)nxt.pm * tstep : cA; const char* nB = has_next ? (const char*)g.Bt + (size_t)nxt.pn * tstep : cB;
        for (int t = 0; t < nt; t += 2) {
            const bool last = (t == nt - 2);
            const char* a1 = cA + (size_t)(t + 1) * kstepA;
            const char* a2 = last ? nA : cA + (size_t)(t + 2) * kstepA; const char* b2 = last ? nB : cB + (size_t)(t + 2) * kstepB;
            const char* a3 = a2 + kstepA; const char* b3 = b2 + kstepB;
            if (last && has_next) S.a_ready(nxt);
            if constexpr (SP2) {
            PG8_LDB(B0, 0, 0); PG8_LDB(B1, 0, 1); PG8_SCHED; PG8_LDA(At, 0, 0); PG8_STAGE(PG8_SA(1, 1), a1 + hstepA, voffA);
            PG8_WAIT_V(8); PG8_WAIT_L(0); PG8_BAR; PG8_MMA(0, 0, At, B0); PG8_MMA(0, 1, At, B1); PG8_BAR; PG8_SCHED;
            PG8_LDA(At, 0, 1); PG8_STAGE(PG8_SB(0, 0), b2, voffB); PG8_STAGE(PG8_SB(0, 1), b2 + hstepB, voffB); PG8_STAGE(PG8_SA(0, 0), a2, voffA);
            PG8_WAIT_V(8); PG8_WAIT_L(0); PG8_BAR; PG8_MMA(1, 0, At, B0); PG8_MMA(1, 1, At, B1); PG8_BAR; PG8_SCHED;
            PG8_LDB(B0, 1, 0); PG8_LDB(B1, 1, 1); PG8_SCHED; PG8_LDA(At, 1, 0); PG8_STAGE(PG8_SA(0, 1), a2 + hstepA, voffA);
            PG8_WAIT_V(8); PG8_WAIT_L(0); PG8_BAR; PG8_MMA(0, 0, At, B0); PG8_MMA(0, 1, At, B1); PG8_BAR; PG8_SCHED;
            PG8_LDA(At, 1, 1); PG8_STAGE(PG8_SB(1, 0), b3, voffB); PG8_STAGE(PG8_SB(1, 1), b3 + hstepB, voffB); PG8_STAGE(PG8_SA(1, 0), a3, voffA);
            PG8_WAIT_V(8); PG8_WAIT_L(0); PG8_BAR; PG8_MMA(1, 0, At, B0); PG8_MMA(1, 1, At, B1); PG8_BAR; PG8_SCHED;
            } else {
            PG8_LDB(B0, 0, 0); PG8_SCHED; PG8_LDA(At, 0, 0); PG8_STAGE(PG8_SA(1, 1), a1 + hstepA, voffA);
            PG8_WAIT_L(8); PG8_BAR; PG8_WAIT_L(0); PG8_MMA(0, 0, At, B0); PG8_BAR; PG8_SCHED;
            PG8_LDB(B1, 0, 1); PG8_STAGE(PG8_SB(0, 0), b2, voffB);
            PG8_BAR; PG8_WAIT_L(0); PG8_MMA(0, 1, At, B1); PG8_BAR;
            PG8_LDA(At, 0, 1); PG8_STAGE(PG8_SA(0, 0), a2, voffA);
            PG8_BAR; PG8_WAIT_L(0); PG8_MMA(1, 0, At, B0); PG8_BAR; PG8_SCHED;
            PG8_STAGE(PG8_SB(0, 1), b2 + hstepB, voffB);
            PG8_WAIT_V(6); PG8_BAR; PG8_MMA(1, 1, At, B1); PG8_BAR;
            PG8_LDB(B0, 1, 0); PG8_SCHED; PG8_LDA(At, 1, 0); PG8_STAGE(PG8_SA(0, 1), a2 + hstepA, voffA);
            PG8_WAIT_L(8); PG8_BAR; PG8_WAIT_L(0); PG8_MMA(0, 0, At, B0); PG8_BAR; PG8_SCHED;
            PG8_LDB(B1, 1, 1); PG8_STAGE(PG8_SB(1, 0), b3, voffB);
            PG8_BAR; PG8_WAIT_L(0); PG8_MMA(0, 1, At, B1); PG8_BAR;
            PG8_LDA(At, 1, 1); PG8_STAGE(PG8_SA(1, 0), a3, voffA);
            PG8_BAR; PG8_WAIT_L(0); PG8_MMA(1, 0, At, B0); PG8_BAR; PG8_SCHED;
            PG8_STAGE(PG8_SB(1, 1), b3 + hstepB, voffB);
            PG8_WAIT_V(6); PG8_BAR; PG8_MMA(1, 1, At, B1); PG8_BAR;
            }
        }
        if constexpr (ALIGN_EPI) { if (wr == 0) PG8_BAR; }
        if constexpr (!Epi::AFTER_DRAIN) { E(acc, cur, wr, wc, fr, fq); S.done(cur); }
        if (!has_next) break;
        if constexpr (Epi::ACC_INIT) { E.init(acc, nxt, wr, wc, fr, fq); } else {
#pragma unroll
        for (int a = 0; a < 2; ++a)
#pragma unroll
            for (int b = 0; b < 2; ++b)
#pragma unroll
                for (int m = 0; m < 4; ++m)
#pragma unroll
                    for (int n = 0; n < 2; ++n) acc[a][b][m][n] = (f32x4){0.f, 0.f, 0.f, 0.f}; }
        cur = nxt; cA = nA; cB = nB; ++ui;
        if constexpr (ALIGN_EPI) { if (wr == 1) PG8_BAR; }
    }
    PG8_WAIT_V(0);
    if constexpr (!ALIGN_EPI) { if (wr == 0) PG8_BAR; }
    PG8_BAR;
    if constexpr (Epi::AFTER_DRAIN) { E.fused(acc, cur, wr, wc, fr, fq, lds, wid, lane); S.done(cur); }
#undef PG8_SA
#undef PG8_SB
#undef PG8_STAGE
#undef PG8_LDA
#undef PG8_LDB
#undef PG8_MMA
#undef PG8_WAIT_V
#undef PG8_WAIT_L
#undef PG8_BAR
#undef PG8_SCHED
}
}
namespace att {
typedef unsigned short bf16;
typedef short bf16x8 __attribute__((ext_vector_type(8)));
typedef short s16x4 __attribute__((ext_vector_type(4)));
typedef float f32x16 __attribute__((ext_vector_type(16)));
typedef float f32x4 __attribute__((ext_vector_type(4)));
typedef unsigned u32x4 __attribute__((ext_vector_type(4)));
constexpr int D = 128, NW = 8, QBLK = 32, KVBLK = 64, QB = NW * QBLK, SEQ = 4096, NHEAD = 16, OPITCH = 2048;
constexpr int SHM_V = KVBLK * D * 2, SHM_K = KVBLK * D * 2;
constexpr int LDS_WS = 2 * SHM_V + 2 * SHM_K;
constexpr int LDS_CT = LDS_WS + NW * 64 * 4;
constexpr int LDS_FLAG = LDS_CT + 2 * 64 * 4;
constexpr int LDS_OST = (LDS_FLAG + 64 + 1023) / 1024 * 1024;
constexpr int LDS_BYTES = LDS_OST + NW * 4096;
#define KSWZ(row, colB) ((row) * 256 + ((colB) ^ (((row) & 7) << 4)))
#define SBAR() __builtin_amdgcn_sched_barrier(0)
__device__ __forceinline__ int v_st(int k, int c) { const int kk = (k & ~0xC) | ((k & 4) << 1) | ((k & 8) >> 1); return ((kk >> 3) * 4 + (c >> 5)) * 512 + ((kk & 7) * 32 + (c & 31)) * 2; }
__device__ __forceinline__ int v_rd_base(int lane) { return ((lane & 3) << 3) | (((lane >> 2) & 3) << 6) | (((lane >> 4) & 1) << 5) | (((lane >> 5) & 1) << 8); }
constexpr int v_rd_off(int d0, int ks, int half) { return d0 * 512 + ks * 4096 + half * 2048; }
__device__ __forceinline__ int crow(int r, int hi) { return (r & 3) + 8 * (r >> 2) + 4 * hi; }
__device__ __forceinline__ unsigned cvtpk(float lo, float hi) { unsigned r; asm volatile("v_cvt_pk_bf16_f32 %0, %1, %2" : "=v"(r) : "v"(lo), "v"(hi)); return r; }
template <int KB>
__device__ __forceinline__ void qkt(f32x16& p0, f32x16& p1, const char* K_lds, int r32, int hi, const bf16x8* qr) {
    p0 = f32x16{}; p1 = f32x16{};
    const char* kb[4];
#pragma unroll
    for (int dd = 0; dd < 4; ++dd) kb[dd] = K_lds + KB * SHM_K + KSWZ(r32, (dd * 16 + hi * 8) * 2);
#pragma unroll
    for (int d0 = 0; d0 < 8; ++d0) { const char* a = kb[d0 & 3] + (d0 >> 2) * 128;
        bf16x8 b0 = *reinterpret_cast<const bf16x8*>(a);
        bf16x8 b1 = *reinterpret_cast<const bf16x8*>(a + 32 * 256);
        p0 = __builtin_amdgcn_mfma_f32_32x32x16_bf16(b0, qr[d0], p0, 0, 0, 0);
        p1 = __builtin_amdgcn_mfma_f32_32x32x16_bf16(b1, qr[d0], p1, 0, 0, 0); }
}
template <int VB>
__device__ __forceinline__ void pv_tile(f32x16* o, int vb0, bf16x8 pa0, bf16x8 pa1, bf16x8 pa2, bf16x8 pa3) {
#define TRRD(dst, off) asm volatile("ds_read_b64_tr_b16 %0, %1 offset:%2" : "=&v"(dst) : "v"(vb0), "i"(off) : "memory")
#define PV_D0(d0) do { s16x4 l0, l1, l2, l3, h0, h1, h2, h3; constexpr int b_ = VB * SHM_V + v_rd_off(d0, 0, 0);   \
        TRRD(l0, b_); TRRD(h0, b_ + 2048); TRRD(l1, b_ + 4096); TRRD(h1, b_ + 6144); TRRD(l2, b_ + 8192); TRRD(h2, b_ + 10240); TRRD(l3, b_ + 12288); TRRD(h3, b_ + 14336); \
        asm volatile("s_waitcnt lgkmcnt(0)" ::: "memory"); SBAR();   \
        o[d0] = __builtin_amdgcn_mfma_f32_32x32x16_bf16(pa0, (bf16x8){l0[0], l0[1], l0[2], l0[3], h0[0], h0[1], h0[2], h0[3]}, o[d0], 0, 0, 0);   \
        o[d0] = __builtin_amdgcn_mfma_f32_32x32x16_bf16(pa1, (bf16x8){l1[0], l1[1], l1[2], l1[3], h1[0], h1[1], h1[2], h1[3]}, o[d0], 0, 0, 0);   \
        o[d0] = __builtin_amdgcn_mfma_f32_32x32x16_bf16(pa2, (bf16x8){l2[0], l2[1], l2[2], l2[3], h2[0], h2[1], h2[2], h2[3]}, o[d0], 0, 0, 0);   \
        o[d0] = __builtin_amdgcn_mfma_f32_32x32x16_bf16(pa3, (bf16x8){l3[0], l3[1], l3[2], l3[3], h3[0], h3[1], h3[2], h3[3]}, o[d0], 0, 0, 0); } while (0)
    PV_D0(0); PV_D0(1); PV_D0(2); PV_D0(3);
#undef PV_D0
#undef TRRD
}
__device__ __forceinline__ void pack_p(const f32x16& p0, const f32x16& p1, bf16x8& pa0, bf16x8& pa1, bf16x8& pa2, bf16x8& pa3) {
#define PK4(P, B_, OUT) do { unsigned a0 = cvtpk(P[B_+0], P[B_+1]), a1 = cvtpk(P[B_+2], P[B_+3]);                          \
        unsigned b0 = cvtpk(P[B_+4], P[B_+5]), b1 = cvtpk(P[B_+6], P[B_+7]);                                             \
        auto r0 = __builtin_amdgcn_permlane32_swap(a0, b0, false, false); auto r1 = __builtin_amdgcn_permlane32_swap(a1, b1, false, false); \
        u32x4 w = {r0[0], r1[0], r0[1], r1[1]}; OUT = *reinterpret_cast<bf16x8*>(&w); } while (0)
    PK4(p0, 0, pa0); PK4(p0, 8, pa1); PK4(p1, 0, pa2); PK4(p1, 8, pa3);
#undef PK4
}
template <bool STRICT>
__device__ __forceinline__ void mask_tile(f32x16& p0, f32x16& p1, int dq) {
    const float NEG = -__builtin_inff();
#pragma unroll
    for (int r = 0; r < 16; ++r) { const int c = (r & 3) + 8 * (r >> 2) + (STRICT ? 1 : 0);
        if (dq - c < 0) p0[r] = NEG;
        if (dq - c - 32 < 0) p1[r] = NEG; }
}
constexpr float THR2 = 8.0f * 1.4426950408889634f;

template <int MODE, int BUF>
__device__ __forceinline__ void tile_compute(f32x16 (&o)[4], float& m_reg, float& l_reg, float& R, const bf16x8* qr, const char* K_lds, int vb0, const float* ct, float* al_l,
                                             volatile __attribute__((address_space(3))) unsigned* flags, int kb, int qlo, int qm, int r32, int hi, int wid, int lane, float wthr, float dqw) {
    if (kb > qlo + QBLK - 1) { if (MODE == 1) { if (lane == 0) flags[BUF * 8 + wid] = __all(R < 1e-30f) ? 1u : 0u; } return; }
    if (MODE == 1) { if (__all(R < 1e-30f)) { if (lane == 0) flags[BUF * 8 + wid] = 1u; return; } }
    if (MODE == 0) { if ((ct[BUF * 64 + 63] - dqw) < -wthr) return; }
    f32x16 p0, p1; bf16x8 pa0, pa1, pa2, pa3;
    qkt<BUF>(p0, p1, K_lds, r32, hi, qr);
    if (MODE == 0) {
#pragma unroll
        for (int g = 0; g < 4; ++g) { const f32x4 b0 = *(const f32x4*)(ct + BUF * 64 + 8 * g + 4 * hi), b1 = *(const f32x4*)(ct + BUF * 64 + 32 + 8 * g + 4 * hi);
#pragma unroll
            for (int i = 0; i < 4; ++i) { p0[4 * g + i] += b0[i]; p1[4 * g + i] += b1[i]; } }
        if (kb + KVBLK - 1 > qlo) mask_tile<false>(p0, p1, qm - kb);
        float pmax = p0[0];
#pragma unroll
        for (int r = 1; r < 16; ++r) pmax = fmaxf(pmax, p0[r]);
#pragma unroll
        for (int r = 0; r < 16; ++r) pmax = fmaxf(pmax, p1[r]);
        { auto rr = __builtin_amdgcn_permlane32_swap(__float_as_uint(pmax), __float_as_uint(pmax), false, false);
          pmax = fmaxf(__uint_as_float(rr[0]), __uint_as_float(rr[1])); }
        float mn, alpha;
        if (__all((pmax - m_reg) <= THR2)) { mn = m_reg; alpha = 1.f; }
        else { mn = fmaxf(m_reg, pmax); alpha = __builtin_amdgcn_exp2f(m_reg - mn); m_reg = mn; }
#pragma unroll
        for (int r = 0; r < 16; ++r) { p0[r] = __builtin_amdgcn_exp2f(p0[r] - mn); p1[r] = __builtin_amdgcn_exp2f(p1[r] - mn); }
        if (__any(alpha < 1.f)) { if (hi == 0) al_l[r32] = alpha; asm volatile("s_waitcnt lgkmcnt(0)" ::: "memory");
#pragma unroll
            for (int d_ = 0; d_ < 4; ++d_)
#pragma unroll
                for (int r = 0; r < 16; ++r) o[d_][r] *= al_l[crow(r, hi)]; }
        float ps = 0.f;
#pragma unroll
        for (int r = 0; r < 16; ++r) ps += p0[r];
#pragma unroll
        for (int r = 0; r < 16; ++r) ps += p1[r];
        { auto rr = __builtin_amdgcn_permlane32_swap(__float_as_uint(ps), __float_as_uint(ps), false, false);
          ps = __uint_as_float(rr[0]) + __uint_as_float(rr[1]); }
        l_reg = l_reg * alpha + ps;
    } else {
        if (kb + KVBLK - 1 >= qlo) mask_tile<true>(p0, p1, qm - kb);
        float t1[8], t2[8], t3[8], P[8];
#pragma unroll
        for (int r = 0; r < 16; ++r) { p0[r] = __builtin_amdgcn_rcpf(1.0f + __builtin_amdgcn_exp2f(p0[r])); p1[r] = __builtin_amdgcn_rcpf(1.0f + __builtin_amdgcn_exp2f(p1[r])); }
#pragma unroll
        for (int g = 0; g < 4; ++g) { t3[g] = p0[4 * g + 3]; t2[g] = t3[g] * p0[4 * g + 2]; t1[g] = t2[g] * p0[4 * g + 1]; P[g] = t1[g] * p0[4 * g];
            t3[g + 4] = p1[4 * g + 3]; t2[g + 4] = t3[g + 4] * p1[4 * g + 2]; t1[g + 4] = t2[g + 4] * p1[4 * g + 1]; P[g + 4] = t1[g + 4] * p1[4 * g]; }
        float E[8]; float accp = R;
#pragma unroll
        for (int g = 7; g >= 0; --g) { auto rr = __builtin_amdgcn_permlane32_swap(__float_as_uint(P[g]), __float_as_uint(P[g]), false, false);
            const float pa = __uint_as_float(rr[0]), pb = __uint_as_float(rr[1]);
            const float eb = accp; accp *= pb; const float ea = accp; accp *= pa; E[g] = hi ? eb : ea; }
        R = accp;
#pragma unroll
        for (int g = 0; g < 4; ++g) { float s3 = E[g], s2 = E[g] * t3[g], s1 = E[g] * t2[g], s0 = E[g] * t1[g];
            p0[4 * g + 3] = s3 - p0[4 * g + 3] * s3; p0[4 * g + 2] = s2 - p0[4 * g + 2] * s2; p0[4 * g + 1] = s1 - p0[4 * g + 1] * s1; p0[4 * g] = s0 - p0[4 * g] * s0;
            s3 = E[g + 4]; s2 = E[g + 4] * t3[g + 4]; s1 = E[g + 4] * t2[g + 4]; s0 = E[g + 4] * t1[g + 4];
            p1[4 * g + 3] = s3 - p1[4 * g + 3] * s3; p1[4 * g + 2] = s2 - p1[4 * g + 2] * s2; p1[4 * g + 1] = s1 - p1[4 * g + 1] * s1; p1[4 * g] = s0 - p1[4 * g] * s0; }
        const bool done = __all(R < 1e-30f);
        if (lane == 0) flags[BUF * 8 + wid] = done ? 1u : 0u;
    }
    pack_p(p0, p1, pa0, pa1, pa2, pa3);
    SBAR();
    pv_tile<BUF>(o, vb0, pa0, pa1, pa2, pa3);
}

template <int MODE>
__device__ __forceinline__ void attn_unit(int b, int h, int qb, const bf16* Q, const bf16* K, const bf16* V, bf16* O, const float* c2, float skip_thr, char* lds) {
    int tid_ = threadIdx.x; asm volatile("" : "+v"(tid_));
    const int tid = tid_, wid = __builtin_amdgcn_readfirstlane(tid >> 6), lane = tid & 63, r32 = lane & 31, hi = lane >> 5;
    const size_t hoff = (size_t)(b * NHEAD + h) * SEQ * D;
    const bf16* Qh = Q + hoff; const bf16* Kh = K + hoff; const bf16* Vh = V + hoff; const float* ch = c2 + (size_t)(b * NHEAD + h) * SEQ;
    const int q0 = qb * QB, qlo = q0 + wid * QBLK, qm = qlo + r32 - 4 * hi;
    char* V_lds = lds; char* K_lds = lds + 2 * SHM_V;
    float* ws = (float*)(lds + LDS_WS) + wid * 64; float* li_l = ws, * al_l = ws + 32;
    float* ct = (float*)(lds + LDS_CT); volatile __attribute__((address_space(3))) unsigned* flags = (volatile __attribute__((address_space(3))) unsigned*)(lds + LDS_FLAG);
    const int sr = tid >> 4, sc = (tid & 15) * 8, vst0 = v_st(sr, sc), vst1 = v_st(32 + sr, sc), kws = KSWZ(sr, sc * 2);
    const int vb0 = (int)(uintptr_t)V_lds + v_rd_base(lane);
    bf16x8 qr[8];
#pragma unroll
    for (int d0 = 0; d0 < 8; ++d0) qr[d0] = *reinterpret_cast<const bf16x8*>(Qh + (size_t)(qlo + r32) * D + d0 * 16 + hi * 8);
    float m_reg = -1e30f, l_reg = 0.f, R = 1.0f; f32x16 o[4] = {};
    const float cref = (MODE == 0) ? ch[q0] : 0.f, dqw = (MODE == 0) ? cref - ch[qlo] : 0.f;
    if (MODE == 1) { if (tid < 16) flags[tid] = 0u; }
    bf16x8 sk0, sk1, sv0, sv1; float sct = 0.f, cleft = 0.f;
#define ATT_LOAD(t_) do { const int kb_ = (t_) * KVBLK; sk0 = *reinterpret_cast<const bf16x8*>(Kh + (size_t)(kb_ + sr) * D + sc); sk1 = *reinterpret_cast<const bf16x8*>(Kh + (size_t)(kb_ + 32 + sr) * D + sc); \
        sv0 = *reinterpret_cast<const bf16x8*>(Vh + (size_t)(kb_ + sr) * D + sc); sv1 = *reinterpret_cast<const bf16x8*>(Vh + (size_t)(kb_ + 32 + sr) * D + sc); \
        if (MODE == 0) { if (tid < 64) sct = ch[kb_ + tid]; cleft = ch[kb_ > 0 ? kb_ - 1 : 0]; } } while (0)
#define ATT_STEP(BUF) { const int kb = t * KVBLK; \
        *(bf16x8*)(K_lds + BUF * SHM_K + kws) = sk0; *(bf16x8*)(K_lds + BUF * SHM_K + kws + 32 * 256) = sk1; *(bf16x8*)(V_lds + BUF * SHM_V + vst0) = sv0; *(bf16x8*)(V_lds + BUF * SHM_V + vst1) = sv1; \
        if (MODE == 0) { if (tid < 64) ct[BUF * 64 + tid] = cref - sct; } \
        __syncthreads();                                                       \
        if (MODE == 1) { unsigned all = 1u; _Pragma("unroll") for (int w = 0; w < 8; ++w) all &= flags[(BUF ^ 1) * 8 + w]; if (all) break; } \
        bool more = t > 0; \
        if (MODE == 0) { if (more) more = !((cref - cleft) < -skip_thr); } \
        if (more) ATT_LOAD(t - 1); \
        tile_compute<MODE, BUF>(o, m_reg, l_reg, R, qr, K_lds, vb0, ct, al_l, flags, kb, qlo, qm, r32, hi, wid, lane, skip_thr, dqw); \
        if (!more) break; --t; }
    int t = (q0 + QB) / KVBLK - 1;
    ATT_LOAD(t);
    for (;;) { ATT_STEP(0) ATT_STEP(1) }
#undef ATT_STEP
#undef ATT_LOAD
    float rli[16];
    if (MODE == 0) { if (hi == 0) li_l[r32] = l_reg; asm volatile("s_waitcnt lgkmcnt(0)" ::: "memory");
#pragma unroll
        for (int r = 0; r < 16; ++r) rli[r] = __builtin_amdgcn_rcpf(li_l[crow(r, hi)]); }
    else {
#pragma unroll
        for (int r = 0; r < 16; ++r) rli[r] = 1.0f; }
    bf16* Ow = O + ((size_t)b * SEQ + qlo) * OPITCH + h * D;
    char* ost = lds + LDS_OST + wid * 4096;
#pragma unroll
    for (int pass = 0; pass < 2; ++pass) {
#pragma unroll
        for (int rr = 0; rr < 8; ++rr) { const int r = pass * 8 + rr, lrow = crow(rr, hi);
#pragma unroll
            for (int d0 = 0; d0 < 4; ++d0) { const float v = o[d0][r] * rli[r]; *(unsigned short*)(ost + lrow * 256 + (d0 * 32 + r32) * 2) = (unsigned short)(cvtpk(v, v) & 0xffffu); } }
        asm volatile("s_waitcnt lgkmcnt(0)" ::: "memory");
#pragma unroll
        for (int j = 0; j < 4; ++j) { const int c = lane + 64 * j, lrow = c >> 4, c16 = c & 15; const u32x4 w = *(const u32x4*)(ost + lrow * 256 + c16 * 16);
            *(u32x4*)(Ow + (size_t)(pass * 16 + lrow) * OPITCH + c16 * 8) = w; }
        asm volatile("s_waitcnt lgkmcnt(0)" ::: "memory");
    }
    __syncthreads();
}
#undef KSWZ
#undef SBAR
}

constexpr int NWAVES = 8;
constexpr int DM = 2048, BATCH = 8, SEQ = 4096, DEPTH = 4, NH = 16, HD = 128, DFF = 5632, NFOX = 2, NSB = 2;
constexpr int M = BATCH * SEQ;
constexpr int FOXW = 3 * DM + NH;
constexpr float QK_SCALE_L2E = 0.08838834764831845f * 1.4426950408889634f;
constexpr float LOG2E = 1.4426950408889634f;

constexpr size_t MiB = 1u << 20;
constexpr size_t WS_CTL = 0, CTL_ZERO_BYTES = 1 * MiB;
constexpr size_t SZ_W1 = (size_t)2 * DFF * DM * 2, SZ_W2 = (size_t)DM * DFF * 2, SZ_WQKV = (size_t)3 * DM * DM * 2, SZ_WO = (size_t)DM * DM * 2;
constexpr size_t WS_W1 = 1 * MiB;
constexpr size_t WS_W2 = WS_W1 + 8 * SZ_W1;
constexpr size_t WS_WQKV = WS_W2 + 8 * SZ_W2;
constexpr size_t WS_WO = WS_WQKV + 4 * SZ_WQKV;
constexpr size_t WS_WF = WS_WO + 4 * SZ_WO;
constexpr size_t WS_SSQ = WS_WF + 1 * MiB;
constexpr size_t WS_RSTD = WS_SSQ + (size_t)M * 32 * 4;
constexpr size_t WS_LF = WS_RSTD + 1 * MiB;
constexpr size_t WS_C2 = WS_LF + (size_t)M * NH * 4;
constexpr size_t WS_XB = WS_C2 + (size_t)M * NH * 4;
constexpr size_t WS_Q = WS_XB + (size_t)M * DM * 2, WS_K = WS_Q + (size_t)M * DM * 2, WS_V = WS_K + (size_t)M * DM * 2;
constexpr size_t WS_O = WS_V + (size_t)M * DM * 2;
constexpr size_t WS_ACT = WS_O + (size_t)M * DM * 2;
constexpr size_t WS_END = WS_ACT + (size_t)M * DFF * 2;
constexpr int CW_BAR = 4096;

constexpr int RING_BYTES = 131072;
constexpr int PRO_WAVE_BYTES = 64 * 65 * 4;
constexpr int LDSCTL_OFF = 8 * PRO_WAVE_BYTES;
constexpr int QKTAB_OFF = LDSCTL_OFF + 256;
constexpr int RTAB_OFF = QKTAB_OFF + 8192;
constexpr int LDS_BYTES = 147456;
static_assert(LDSCTL_OFF >= RING_BYTES && RTAB_OFF + 2048 <= LDS_BYTES && att::LDS_BYTES <= RING_BYTES, "LDS map");

#define GAS __attribute__((address_space(1)))
#define LAS __attribute__((address_space(3)))
typedef unsigned short bf16;
typedef unsigned v4u __attribute__((ext_vector_type(4)));
typedef unsigned v2u __attribute__((ext_vector_type(2)));
typedef float f32x4 __attribute__((ext_vector_type(4)));
#define LDS_WAIT() asm volatile("s_waitcnt lgkmcnt(0)" ::: "memory")
__device__ __forceinline__ unsigned f2bf(float f) { unsigned u = __builtin_bit_cast(unsigned, f); return (u + 0x7fffu + ((u >> 16) & 1u)) >> 16; }
__device__ __forceinline__ unsigned pk2(float lo, float hi) { unsigned r; asm("v_cvt_pk_bf16_f32 %0, %1, %2" : "=v"(r) : "v"(lo), "v"(hi)); return r; }
__device__ __forceinline__ float bf2f(unsigned short v) { return __builtin_bit_cast(float, (unsigned)v << 16); }

#define XB_TMO      128
#define XB_XCNT(j)  (256  + 64 * (j))
#define XB_XSUB(j)  (1280 + 64 * (j))
#define XB_XGEN(j)  (2304 + 64 * (j))
#define XB_TOP      3328
#define XB_TOPGEN   3392
#define XCD_BAR_WORDS 3456
#define XB_SPIN_CAP (1u << 18)

__device__ __forceinline__ unsigned xb_ld(unsigned* p)              { return __hip_atomic_load(p, __ATOMIC_RELAXED, __HIP_MEMORY_SCOPE_AGENT); }
__device__ __forceinline__ unsigned xb_add(unsigned* p, unsigned v) { return __hip_atomic_fetch_add(p, v, __ATOMIC_RELAXED, __HIP_MEMORY_SCOPE_AGENT); }
__device__ __forceinline__ unsigned xb_xcc_id() { return (unsigned)__builtin_amdgcn_s_getreg((3 << 11) | 20) & 0xFu; }
#define XB_SPIN(cond, bar) do { unsigned _sp = 0; while (cond) { __builtin_amdgcn_s_sleep(1); \
    if ((++_sp & 255u) == 0u) { if (xb_ld(&(bar)[XB_TMO])) break; if (_sp > XB_SPIN_CAP) { atomicAdd(&(bar)[XB_TMO], 1u); break; } } } } while (0)

struct XcdBarrier {
    unsigned* bar; unsigned x; unsigned nmem;
    volatile LAS unsigned* st;
};

__device__ __forceinline__ XcdBarrier xcd_barrier_post(unsigned* bar, volatile LAS unsigned* st, unsigned nmem) {
    XcdBarrier b; b.bar = bar; b.x = xb_xcc_id(); b.st = st; b.nmem = nmem;
    if (threadIdx.x == 0) (void)xb_add(&bar[XB_XCNT(b.x)], 1u);
    return b;
}
__device__ __forceinline__ void xcd_barrier_complete(unsigned* bar, unsigned x, unsigned G, unsigned& nloc, unsigned& nx) {
    unsigned sum, cnt, mine, sp = 0u;
    for (;;) {
        sum = 0u; cnt = 0u; mine = 0u;
#pragma unroll
        for (unsigned j = 0; j < 16; ++j) { const unsigned c = xb_ld(&bar[XB_XCNT(j)]); sum += c; cnt += (c > 0u) ? 1u : 0u; mine = (j == x) ? c : mine; }
        if (sum == G) break;
        __builtin_amdgcn_s_sleep(1);
        if ((++sp & 255u) == 0u) { if (xb_ld(&bar[XB_TMO])) break; if (sp > XB_SPIN_CAP) { atomicAdd(&bar[XB_TMO], 1u); break; } }
    }
    nloc = mine > 0u ? mine : 1u; nx = cnt > 0u ? cnt : 1u;
}

__device__ __forceinline__ void xcd_barrier(const XcdBarrier& b) {
    asm volatile("s_waitcnt vmcnt(0)" ::: "memory");
    __syncthreads();
    if (threadIdx.x == 0) {
        unsigned* bar = b.bar;
        __builtin_amdgcn_s_waitcnt(0);
        unsigned nloc = b.st[0], nx = b.st[1];
        if (nloc == 0u) { xcd_barrier_complete(bar, b.x, b.nmem, nloc, nx); b.st[0] = nloc; b.st[1] = nx; }
        const unsigned old = xb_add(&bar[XB_XSUB(b.x)], 1u);
        const unsigned gen = old / nloc;
        if (old + 1u == (gen + 1u) * nloc) {
            __builtin_amdgcn_fence(__ATOMIC_RELEASE, "agent");
            asm volatile("s_waitcnt vmcnt(0)" ::: "memory");
            const unsigned og = xb_add(&bar[XB_TOP], 1u);
            const unsigned tg = og / nx;
            if (og + 1u == (tg + 1u) * nx) xb_add(&bar[XB_TOPGEN], 1u);
            else XB_SPIN(xb_ld(&bar[XB_TOPGEN]) == tg, bar);
            __builtin_amdgcn_fence(__ATOMIC_ACQUIRE, "agent");
            xb_add(&bar[XB_XGEN(b.x)], 1u);
            asm volatile("s_waitcnt vmcnt(0)" ::: "memory");
        } else {
            XB_SPIN(xb_ld(&bar[XB_XGEN(b.x)]) == gen, bar);
            __builtin_amdgcn_fence(__ATOMIC_ACQUIRE, "agent");
            asm volatile("s_waitcnt vmcnt(0)" ::: "memory");
        }
    }
    __syncthreads();
}

__device__ __forceinline__ float wave_sum(float v) {
#pragma unroll
    for (int o = 1; o < 64; o <<= 1) v += __shfl_xor(v, o);
    return v;
}
__device__ __forceinline__ void tr_item(const float* W, int ldw, int K, int k0, int n0, const float* g, bf16* WT, int drow0, LAS float* scr, int lane) {
#pragma unroll 4
    for (int i = 0; i < 16; ++i) { const int kk = 4 * i + (lane >> 4), c = (lane & 15) * 4;
        const f32x4 v = *(const GAS f32x4*)(W + (size_t)(k0 + kk) * ldw + n0 + c);
        LAS float* d = scr + kk * 65 + c; d[0] = v.x; d[1] = v.y; d[2] = v.z; d[3] = v.w; }
    LDS_WAIT(); asm volatile("" ::: "memory");
    const int c8 = lane & 7;
    f32x4 ga = (f32x4){1.f, 1.f, 1.f, 1.f}, gb = ga;
    if (g) { ga = *(const f32x4*)(g + k0 + 8 * c8); gb = *(const f32x4*)(g + k0 + 8 * c8 + 4); }
#pragma unroll
    for (int j = 0; j < 8; ++j) { const int n = (lane >> 3) + 8 * j; const LAS float* s = scr + (8 * c8) * 65 + n;
        v4u o; o.x = pk2(s[0 * 65] * ga.x, s[1 * 65] * ga.y); o.y = pk2(s[2 * 65] * ga.z, s[3 * 65] * ga.w); o.z = pk2(s[4 * 65] * gb.x, s[5 * 65] * gb.y); o.w = pk2(s[6 * 65] * gb.z, s[7 * 65] * gb.w);
        const int dr = drow0 + n; *(GAS v4u*)(WT + ((size_t)(dr >> 8) * (K >> 6) + (k0 >> 6)) * 16384 + (dr & 255) * 64 + 8 * c8) = o; }
    LDS_WAIT(); asm volatile("" ::: "memory");
}

#define XBAR() do { XcdBarrier b_; b_.bar = (unsigned*)(args.ws + WS_CTL) + CW_BAR + 8 * XCD_BAR_WORDS; b_.x = xb_xcc_id(); b_.nmem = (unsigned)G; b_.st = (volatile LAS unsigned*)((LAS unsigned char*)lds + LDSCTL_OFF) + 8; xcd_barrier(b_); } while (0)
#define CBAR() do { XcdBarrier b_; b_.bar = (unsigned*)(args.ws + WS_CTL) + CW_BAR + cls * XCD_BAR_WORDS; b_.x = xb_xcc_id(); b_.nmem = (unsigned)GC; b_.st = (volatile LAS unsigned*)((LAS unsigned char*)lds + LDSCTL_OFF) + 10; xcd_barrier(b_); } while (0)
struct Args {
    const float* x; const float* norm_g; const float* ffn_w_in; const float* ffn_w_out; const float* fox_w_in; const float* fox_b_f; const float* fox_qk_g; const float* sb_w_in; const float* w_o;
    float* out; unsigned char* ws;
};

__global__ void __launch_bounds__(NWAVES * 64, 2) mk_fwd(Args args) {
    extern __shared__ __attribute__((aligned(16))) unsigned char lds[];
    LAS unsigned char* ldsl = (LAS unsigned char*)lds;
    const int tid = threadIdx.x, lane = tid & 63, wave = __builtin_amdgcn_readfirstlane(tid >> 6);
    const int G = gridDim.x, bx = blockIdx.x;
    const int vcu = (G % 8 == 0) ? (bx % 8) * (G / 8) + bx / 8 : bx;
    unsigned char* ws = args.ws;
    volatile LAS unsigned* MISC = (volatile LAS unsigned*)(ldsl + LDSCTL_OFF);
    if (tid < 64) MISC[tid] = 0u;
    __syncthreads();
    const int ncls = (G % 8 == 0) ? 8 : 1, cls = bx % ncls, cj = bx / ncls, GC = G / ncls, BPC = BATCH / ncls;
    (void)xcd_barrier_post((unsigned*)(ws + WS_CTL) + CW_BAR + 8 * XCD_BAR_WORDS, MISC + 8, (unsigned)G);
    (void)xcd_barrier_post((unsigned*)(ws + WS_CTL) + CW_BAR + cls * XCD_BAR_WORDS, MISC + 10, (unsigned)GC);

    bf16* W1T = (bf16*)(ws + WS_W1); bf16* W2T = (bf16*)(ws + WS_W2); bf16* WQKVT = (bf16*)(ws + WS_WQKV); bf16* WOT = (bf16*)(ws + WS_WO);
    bf16* WFT = (bf16*)(ws + WS_WF); float* SSQ = (float*)(ws + WS_SSQ); float* RSTD = (float*)(ws + WS_RSTD); float* LF = (float*)(ws + WS_LF); float* C2 = (float*)(ws + WS_C2);
    bf16* XB = (bf16*)(ws + WS_XB); bf16* QB_ = (bf16*)(ws + WS_Q); bf16* KB_ = (bf16*)(ws + WS_K); bf16* VB_ = (bf16*)(ws + WS_V); bf16* OB = (bf16*)(ws + WS_O); bf16* ACT = (bf16*)(ws + WS_ACT);
    const int gw = vcu * NWAVES + wave, NGW = G * NWAVES;

    {
        LAS float* scr = (LAS float*)(ldsl + wave * PRO_WAVE_BYTES);
        constexpr int I_W1 = 32 * 176, I_W2 = 88 * 32, I_QKV = 32 * 96, I_WO = 32 * 32;
        constexpr int NITEMS = 8 * I_W1 + 8 * I_W2 + 4 * I_QKV + 4 * I_WO;
        for (int it = gw; it < NITEMS; it += NGW) {
            int r = it;
            if (r < 8 * I_W1) { const int mi = r / I_W1, q = r % I_W1, kb = q / 176, nb = q % 176, layer = mi >> 1, f = mi & 1;
                const int n0 = nb * 64, half = n0 / DFF, j0 = n0 % DFF, drow = 256 * (j0 / 128) + 128 * half + (j0 % 128);
                tr_item(args.ffn_w_in + (size_t)mi * DM * 2 * DFF, 2 * DFF, DM, kb * 64, n0, args.norm_g + (size_t)(layer * 3 + (f ? 2 : 0)) * DM, W1T + (size_t)mi * 2 * DFF * DM, drow, scr, lane); continue; }
            r -= 8 * I_W1;
            if (r < 8 * I_W2) { const int mi = r / I_W2, q = r % I_W2, kb = q / 32, nb = q % 32;
                tr_item(args.ffn_w_out + (size_t)mi * DFF * DM, DM, DFF, kb * 64, nb * 64, nullptr, W2T + (size_t)mi * DM * DFF, nb * 64, scr, lane); continue; }
            r -= 8 * I_W2;
            if (r < 4 * I_QKV) { const int layer = r / I_QKV, q = r % I_QKV, kb = q / 96, nb = q % 96, j = layer >> 1;
                const float* W = (layer & 1) ? args.sb_w_in + (size_t)j * DM * 3 * DM : args.fox_w_in + (size_t)j * DM * FOXW; const int ldw = (layer & 1) ? 3 * DM : FOXW;
                tr_item(W, ldw, DM, kb * 64, nb * 64, args.norm_g + (size_t)(layer * 3 + 1) * DM, WQKVT + (size_t)layer * 3 * DM * DM, nb * 64, scr, lane); continue; }
            r -= 4 * I_QKV;
            { const int layer = r / I_WO, q = r % I_WO, kb = q / 32, nb = q % 32;
                tr_item(args.w_o + (size_t)layer * DM * DM, DM, DM, kb * 64, nb * 64, nullptr, WOT + (size_t)layer * DM * DM, nb * 64, scr, lane); }
        }
        for (int i = gw * 64 + lane; i < NFOX * NH * DM; i += NGW * 64) { const int j = i / (DM * NH), h = (i / DM) % NH, k = i % DM;
            WFT[i] = (bf16)f2bf(args.norm_g[(size_t)((2 * j) * 3 + 1) * DM + k] * args.fox_w_in[(size_t)j * DM * FOXW + (size_t)k * FOXW + 3 * DM + h]); }
        for (int m = gw; m < M; m += NGW) {
            const GAS f32x4* xr = (const GAS f32x4*)(args.x + (size_t)m * DM) + lane; GAS v2u* o8 = (GAS v2u*)(XB + (size_t)m * DM) + lane; float s = 0.f;
#pragma unroll
            for (int j = 0; j < 8; ++j) { const f32x4 v = xr[64 * j]; s += (v.x * v.x + v.y * v.y) + (v.z * v.z + v.w * v.w); v2u w; w.x = pk2(v.x, v.y); w.y = pk2(v.z, v.w); o8[64 * j] = w; }
            s = wave_sum(s);
            if (lane == 0) RSTD[m] = 1.0f / sqrtf(s * (1.0f / DM) + 1e-6f);
        }
    }
    XBAR();

#define RSTD_PASS(GATE, jfox) do { int lane_o = threadIdx.x & 63; asm volatile("" : "+v"(lane_o)); const int ln = lane_o; \
        for (int tile = cj * NWAVES + wave; tile < BPC * SEQ / 16; tile += GC * NWAVES) { const int r0 = cls * BPC * SEQ + tile * 16; \
            const f32x4* p = (const f32x4*)(SSQ + (size_t)(r0 + (ln >> 2)) * 32 + (ln & 3) * 8); const f32x4 sv = p[0] + p[1]; float t = (sv[0] + sv[1]) + (sv[2] + sv[3]); \
            t += __shfl_xor(t, 1); t += __shfl_xor(t, 2); const float rs = 1.0f / sqrtf(t * (1.0f / DM) + 1e-6f); if ((ln & 3) == 0) RSTD[r0 + (ln >> 2)] = rs; \
            if (GATE) { const bf16* ap = XB + (size_t)(r0 + (ln & 15)) * DM + 8 * (ln >> 4); const bf16* bp = WFT + ((size_t)(jfox) * NH + (ln & 15)) * DM + 8 * (ln >> 4); \
                pg8::f32x4 ga = (pg8::f32x4){0.f, 0.f, 0.f, 0.f}; \
                _Pragma("unroll 8") for (int kk = 0; kk < DM / 32; ++kk) { const pg8::bf16x8 a = *(const pg8::bf16x8*)(ap + kk * 32), bq = *(const pg8::bf16x8*)(bp + kk * 32); ga = __builtin_amdgcn_mfma_f32_16x16x32_bf16(a, bq, ga, 0, 0, 0); } \
                const float bfv = args.fox_b_f[(jfox) * NH + (ln & 15)]; f32x4 o; \
                _Pragma("unroll") for (int r = 0; r < 4; ++r) { const float rr = __shfl(rs, 4 * (4 * (ln >> 4) + r)); const float v = ga[r] * rr + bfv; o[r] = fminf(v, 0.f) - log1pf(expf(-fabsf(v))); } \
                const int bb = r0 / SEQ, ss = r0 % SEQ + 4 * (ln >> 4); *(f32x4*)(LF + ((size_t)bb * NH + (ln & 15)) * SEQ + ss) = o; } } } while (0)
    for (int blk = 0; blk < 3 * DEPTH; ++blk) {
        const int layer = blk / 3, sub = blk % 3;
        const bf16* rA; const bf16* rB; int rK, rAt; float ralpha, rinv;
        if (sub != 1) {
            const int mi = layer * 2 + (sub >> 1);
            {
                pg8::Gemm g{XB, W1T + (size_t)mi * 2 * DFF * DM, M, 2 * DFF, DM, 0, 1}; pg8::RstdOrder S; S.init(M, 2 * DFF, G, bx); S.rstd = RSTD; S.tab = ldsl + RTAB_OFF;
                pg8::EpiSwiGLU E{ACT, DFF, (const PG8_LAS float*)(ldsl + RTAB_OFF)};
                pg8::gemm_phase<pg8::EpiSwiGLU, pg8::RstdOrder, true, true>(ldsl, g, S, E);
            }
            CBAR();
            rA = ACT; rB = W2T + (size_t)mi * DM * DFF; rK = DFF; rAt = 1; ralpha = 0.5f; rinv = 2.0f;
        } else {
            const int fox = !(layer & 1), j = layer >> 1;
            {
                pg8::Gemm g{XB, WQKVT + (size_t)layer * 3 * DM * DM, M, 3 * DM, DM, 0, 1}; pg8::RstdOrder S; S.init(M, 3 * DM, G, bx); S.rstd = RSTD; S.tab = ldsl + RTAB_OFF;
                pg8::EpiQKV E{QB_, (size_t)M * DM, (const PG8_LAS float*)(ldsl + RTAB_OFF), QK_SCALE_L2E, fox ? args.fox_qk_g + (size_t)j * 2 * HD : nullptr, (PG8_LAS float*)(ldsl + QKTAB_OFF)};
                pg8::gemm_phase<pg8::EpiQKV, pg8::RstdOrder, true, true>(ldsl, g, S, E);
            }
            CBAR();
            float skip_thr = 0.f;
            if (fox) {
                int lane_o = threadIdx.x & 63; asm volatile("" : "+v"(lane_o)); const int lane = lane_o;
                if (cj * NWAVES + wave < BPC * NH) { const int sq_ = cls * BPC * NH + cj * NWAVES + wave; const float* src = LF + (size_t)sq_ * SEQ + lane * 64; float* dst = C2 + (size_t)sq_ * SEQ + lane * 64;
                    float v[64]; float run = 0.f;
#pragma unroll
                    for (int i = 0; i < 16; ++i) { const f32x4 t = *(const f32x4*)(src + 4 * i); run += t.x; v[4 * i] = run; run += t.y; v[4 * i + 1] = run; run += t.z; v[4 * i + 2] = run; run += t.w; v[4 * i + 3] = run; }
                    float incl = run;
#pragma unroll
                    for (int o = 1; o < 64; o <<= 1) { const float t = __shfl_up(incl, o); if (lane >= o) incl += t; }
                    const float pre = incl - run;
#pragma unroll
                    for (int i = 0; i < 16; ++i) { f32x4 t; t.x = (v[4 * i] + pre) * LOG2E; t.y = (v[4 * i + 1] + pre) * LOG2E; t.z = (v[4 * i + 2] + pre) * LOG2E; t.w = (v[4 * i + 3] + pre) * LOG2E; *(f32x4*)(dst + 4 * i) = t; } }
                CBAR();
                const float* qkg = args.fox_qk_g + (size_t)j * 2 * HD;
                float gq = fmaxf(fabsf(qkg[lane]), fabsf(qkg[lane + 64])), gk = fmaxf(fabsf(qkg[HD + lane]), fabsf(qkg[HD + lane + 64]));
#pragma unroll
                for (int o_ = 1; o_ < 64; o_ <<= 1) { gq = fmaxf(gq, __shfl_xor(gq, o_)); gk = fmaxf(gk, __shfl_xor(gk, o_)); }
                skip_thr = (30.0f + 2.0f * 11.3137085f * 1.02f * gq * gk) * LOG2E; }
            for (int i2 = 0; ; ++i2) { const int L = (i2 >> 1) * GC + cj; if (L >= BPC * NH * 8) break;
                const int bh = cls * BPC * NH + (L >> 3), x = (i2 & 1) ? 15 - (L & 7) : (L & 7), b = bh / NH, h = bh % NH;
                if (fox) att::attn_unit<0>(b, h, x, QB_, KB_, VB_, OB, C2, skip_thr, (char*)lds);
                else     att::attn_unit<1>(b, h, x, QB_, KB_, VB_, OB, C2, 0.f, (char*)lds); }
            CBAR();
            rA = OB; rB = WOT + (size_t)layer * DM * DM; rK = DM; rAt = 0; ralpha = 1.0f; rinv = 1.0f;
        }
        {
            pg8::Gemm g{rA, rB, M, DM, rK, rAt, 1}; pg8::StaticOrder S; S.init(M, DM, G, bx, 0, 0, 4);
            pg8::EpiResid E{args.out, XB, SSQ, ralpha, rinv, DM, blk == 3 * DEPTH - 1};
            pg8::gemm_phase<pg8::EpiResid, pg8::StaticOrder, true, true>(ldsl, g, S, E);
        }
        if (blk == 3 * DEPTH - 1) break;
        CBAR();
        { const bool gate = (sub == 0) && !(layer & 1); const int jf = layer >> 1; RSTD_PASS(gate, jf); }
        CBAR();
    }
}

extern "C" void kernel_launch(void* const* d_in, const int* in_sizes, int n_in, void* d_out, int out_size, void* d_ws, size_t ws_size, hipStream_t stream) {
    static int grid = 0;
    if (grid == 0) {
        if (n_in != 9 || in_sizes[0] != M * DM || out_size != M * DM || ws_size < WS_END) { fprintf(stderr, "kernel_launch: unexpected shapes (n_in %d, in0 %d, out %d, ws %zu < %zu)\n", n_in, n_in > 0 ? in_sizes[0] : -1, out_size, ws_size, (size_t)WS_END); grid = -1; return; }
        int dev = 0, cus = 0, per_cu = 0;
        if (hipGetDevice(&dev) != hipSuccess || hipDeviceGetAttribute(&cus, hipDeviceAttributeMultiprocessorCount, dev) != hipSuccess) { grid = -1; return; }
        if (hipFuncSetAttribute((const void*)mk_fwd, hipFuncAttributeMaxDynamicSharedMemorySize, LDS_BYTES) != hipSuccess) { fprintf(stderr, "kernel_launch: hipFuncSetAttribute failed\n"); grid = -1; return; }
        if (hipOccupancyMaxActiveBlocksPerMultiprocessor(&per_cu, (const void*)mk_fwd, NWAVES * 64, LDS_BYTES) != hipSuccess || per_cu < 1) fprintf(stderr, "kernel_launch: occupancy query reports %d\n", per_cu);
        (void)hipGetLastError();
        grid = cus;
    }
    if (grid < 0) return;
    if (hipMemsetAsync((char*)d_ws + WS_CTL, 0, CTL_ZERO_BYTES, stream) != hipSuccess) return;
    Args a{};
    a.x = (const float*)d_in[0]; a.norm_g = (const float*)d_in[1]; a.ffn_w_in = (const float*)d_in[2]; a.ffn_w_out = (const float*)d_in[3]; a.fox_w_in = (const float*)d_in[4];
    a.fox_b_f = (const float*)d_in[5]; a.fox_qk_g = (const float*)d_in[6]; a.sb_w_in = (const float*)d_in[7]; a.w_o = (const float*)d_in[8];
    a.out = (float*)d_out; a.ws = (unsigned char*)d_ws;
    hipLaunchKernelGGL(mk_fwd, dim3(grid), dim3(NWAVES * 64), LDS_BYTES, stream, a);
}
```

```cpp
#include <hip/hip_runtime.h>
#include <cstdio>
#include <cstdint>
namespace pg8 {
#define PG8_LAS __attribute__((address_space(3)))
typedef unsigned short bf16_t;
typedef short bf16x8 __attribute__((ext_vector_type(8)));
typedef float f32x4 __attribute__((ext_vector_type(4)));
typedef unsigned u32x4 __attribute__((ext_vector_type(4)));
constexpr int BM = 256, BK = 64, HALF = 128, HTB = HALF * BK * 2  , STAGE_BYTES = 8 * HTB, NXCD = 8, WGM = 8;

__host__ __device__ __forceinline__ int lds_byte(int r, int c) { const int st = (r >> 4) * 2 + (c >> 5), rr = r & 15, cc = c & 31, ob = rr * 64 + cc * 2; return st * 1024 + (ob ^ (((ob >> 9) & 1) << 5)); }
__host__ __device__ __forceinline__ void stage_rc(int b, int& R, int& C) { const int st = b / 1024, sb = b % 1024, swz = sb ^ (((sb >> 9) & 1) << 5); R = (st >> 1) * 16 + swz / 64; C = (st & 1) * 32 + (swz % 64) / 2; }
__host__ __device__ __forceinline__ int perm32(int rho) { const int n = rho >> 4, i = rho & 15; return 8 * (i >> 2) + 4 * n + (i & 3); }

struct Unit { int pm, pn; };
struct Gemm { const bf16_t* A; const bf16_t* Bt; int M, N, K; int atile, btile; };

struct StaticOrder {
    int nM, nN, nwg, G, c, i0, i1, wgm;
    __host__ __device__ void init(int M, int N, int G_, int c_, int i0_ = 0, int i1_ = 0, int wgm_ = WGM) { nM = M / BM; nN = N / BM; nwg = nM * nN; G = G_; c = c_; i0 = i0_; i1 = i1_; wgm = wgm_; }
    __host__ __device__ bool next(int i, Unit& u) const {
        i += i0; if (i1 > 0 && i >= i1) return false;
        const long L = (long)i * G + c; if (L >= nwg) return false;
        int wgid = (int)L; { const int q = nwg / NXCD, r = nwg % NXCD, xcd = wgid % NXCD, off = wgid / NXCD; wgid = (xcd < r ? xcd * (q + 1) : r * (q + 1) + (xcd - r) * q) + off; }
        const int nig = wgm * nN, gid = wgid / nig, fm = gid * wgm, gsz = (nM - fm) < wgm ? (nM - fm) : wgm;
        u.pm = fm + ((wgid % nig) % gsz); u.pn = (wgid % nig) / gsz; return true;
    }
    __device__ __forceinline__ void a_ready(const Unit&) const {}
    __device__ __forceinline__ void done(const Unit&) const {}
};
struct RstdOrder : StaticOrder {
    const float* rstd; PG8_LAS unsigned char* tab;
    __device__ __forceinline__ void a_ready(const Unit& u) const {
        int t_ = threadIdx.x; asm volatile("" : "+v"(t_));
        if (__builtin_amdgcn_readfirstlane(t_ >> 6) == 0) {
            const float* src = rstd + (size_t)u.pm * BM + (t_ & 63) * 4;
            __builtin_amdgcn_global_load_lds((const unsigned*)src, (PG8_LAS unsigned*)(tab + ((u.pm >> 3) & 1) * 1024), 16, 0, 0); }
    }
};


__device__ __forceinline__ unsigned cvt_pk_bf16(float lo, float hi) { unsigned r; asm volatile("v_cvt_pk_bf16_f32 %0, %1, %2" : "=v"(r) : "v"(lo), "v"(hi)); return r; }
typedef float f32x2 __attribute__((ext_vector_type(2)));
constexpr int SSQ_W = 32;
constexpr float RMS_EPS = 1e-6f, INV_DM = 1.0f / 2048.0f;
struct EpiSwiGLU {
    static constexpr bool PERM = true, AFTER_DRAIN = false, ACC_INIT = false;
    bf16_t* O; int ldo; const PG8_LAS float* rtab;
    __device__ __forceinline__ void operator()(const f32x4 (&acc)[2][2][4][2], const Unit& u, int wr, int wc, int fr, int fq) const {
        const int row0 = u.pm * BM + wr * 64 + fr, col0 = u.pn * HALF + wc * 32 + 8 * fq;
        float rsv[2][4];
#pragma unroll
        for (int ai = 0; ai < 2; ++ai)
#pragma unroll
            for (int m = 0; m < 4; ++m) rsv[ai][m] = rtab[((u.pm >> 3) & 1) * 256 + ai * HALF + wr * 64 + m * 16 + fr];
#pragma unroll
        for (int ai = 0; ai < 2; ++ai)
#pragma unroll
            for (int m = 0; m < 4; ++m) { const int row = row0 + ai * HALF + m * 16; const float rs = rsv[ai][m];
                const float c1 = rs * -1.4426950408889634f, irs2 = __builtin_amdgcn_rcpf(rs * rs); f32x2 ex[4], gu[4];
#pragma unroll
                for (int n = 0; n < 2; ++n)
#pragma unroll
                    for (int i = 0; i < 2; ++i) { const f32x2 g = (f32x2){acc[ai][0][m][n][2 * i], acc[ai][0][m][n][2 * i + 1]}, up = (f32x2){acc[ai][1][m][n][2 * i], acc[ai][1][m][n][2 * i + 1]};
                        ex[n * 2 + i] = g * c1; gu[n * 2 + i] = g * up; }
#pragma unroll
                for (int k = 0; k < 4; ++k) { ex[k].x = __builtin_amdgcn_exp2f(ex[k].x); ex[k].y = __builtin_amdgcn_exp2f(ex[k].y); }
#pragma unroll
                for (int k = 0; k < 4; ++k) ex[k] = ex[k] * irs2 + irs2;
#pragma unroll
                for (int k = 0; k < 4; ++k) { ex[k].x = __builtin_amdgcn_rcpf(ex[k].x); ex[k].y = __builtin_amdgcn_rcpf(ex[k].y); }
#pragma unroll
                for (int k = 0; k < 4; ++k) gu[k] = gu[k] * ex[k];
                u32x4 w; w.x = cvt_pk_bf16(gu[0].x, gu[0].y); w.y = cvt_pk_bf16(gu[1].x, gu[1].y); w.z = cvt_pk_bf16(gu[2].x, gu[2].y); w.w = cvt_pk_bf16(gu[3].x, gu[3].y);
                *(u32x4*)(O + (((size_t)u.pm * (ldo / 64) + 2 * u.pn + (wc >> 1)) * BM + (row - u.pm * BM)) * 64 + (wc & 1) * 32 + 8 * fq) = w; }
    }
};
struct EpiResid {
    static constexpr bool PERM = true, AFTER_DRAIN = false, ACC_INIT = true;
    float* out; bf16_t* xh; float* ssq; float alpha, inv_alpha; int ldc; bool final_;
    __device__ __forceinline__ static f32x4 up4(unsigned a, unsigned b) { return (f32x4){__builtin_bit_cast(float, a << 16), __builtin_bit_cast(float, a & 0xffff0000u), __builtin_bit_cast(float, b << 16), __builtin_bit_cast(float, b & 0xffff0000u)}; }
    __device__ __forceinline__ void init(f32x4 (&acc)[2][2][4][2], const Unit& u, int wr, int wc, int fr, int fq) const {
        const int row0 = u.pm * BM + wr * 64 + fr, col0 = u.pn * BM + wc * 32 + 8 * fq;
#pragma unroll
        for (int ai = 0; ai < 2; ++ai)
#pragma unroll
            for (int m = 0; m < 4; ++m) { const size_t off = (size_t)(row0 + ai * HALF + m * 16) * ldc + col0;
#pragma unroll
                for (int bj = 0; bj < 2; ++bj) { const u32x4 h = *(const u32x4*)(xh + off + bj * HALF);
                    acc[ai][bj][m][0] = up4(h.x, h.y) * inv_alpha; acc[ai][bj][m][1] = up4(h.z, h.w) * inv_alpha; } }
    }
    __device__ __forceinline__ void operator()(const f32x4 (&acc)[2][2][4][2], const Unit& u, int wr, int wc, int fr, int fq) const {
        const int row0 = u.pm * BM + wr * 64 + fr, col0 = u.pn * BM + wc * 32 + 8 * fq;
        float sv[2][4];
#pragma unroll
        for (int ai = 0; ai < 2; ++ai)
#pragma unroll
            for (int m = 0; m < 4; ++m) { const int row = row0 + ai * HALF + m * 16; const size_t off = (size_t)row * ldc + col0; float s = 0.f;
#pragma unroll
                for (int bj = 0; bj < 2; ++bj) { const f32x4 o0 = acc[ai][bj][m][0] * alpha, o1 = acc[ai][bj][m][1] * alpha;
                    s += ((o0[0] * o0[0] + o0[1] * o0[1]) + (o0[2] * o0[2] + o0[3] * o0[3])) + ((o1[0] * o1[0] + o1[1] * o1[1]) + (o1[2] * o1[2] + o1[3] * o1[3]));
                    if (final_) { *(f32x4*)(out + off + bj * HALF) = o0; *(f32x4*)(out + off + bj * HALF + 4) = o1; }
                    else { u32x4 h; h.x = cvt_pk_bf16(o0[0], o0[1]); h.y = cvt_pk_bf16(o0[2], o0[3]); h.z = cvt_pk_bf16(o1[0], o1[1]); h.w = cvt_pk_bf16(o1[2], o1[3]);
                           *(u32x4*)(xh + off + bj * HALF) = h; } }
                s += __shfl_xor(s, 16); s += __shfl_xor(s, 32); sv[ai][m] = s; }
        if (!final_) {
#pragma unroll
            for (int ai = 0; ai < 2; ++ai) { const float s = fq == 0 ? sv[ai][0] : (fq == 1 ? sv[ai][1] : (fq == 2 ? sv[ai][2] : sv[ai][3]));
                ssq[(size_t)(row0 + ai * HALF + fq * 16) * SSQ_W + u.pn * 4 + wc] = s; } }
    }
};
struct EpiQKV {
    static constexpr bool PERM = true, AFTER_DRAIN = false, ACC_INIT = false;
    bf16_t* Q; size_t tstride; const PG8_LAS float* rtab; float qscale; const float* qkg; PG8_LAS float* tab;
    __device__ __forceinline__ void operator()(const f32x4 (&acc)[2][2][4][2], const Unit& u, int wr, int wc, int fr, int fq) const {
        const int which = u.pn >> 3, hp = u.pn & 7;
        bf16_t* dst = Q + (size_t)which * tstride; const float sc = which == 0 ? qscale : 1.0f;
        const int row0 = u.pm * BM + wr * 64 + fr, b = u.pm >> 4, s0 = (u.pm & 15) * BM + wr * 64 + fr, d0 = wc * 32 + 8 * fq;
        float rsv[2][4];
#pragma unroll
        for (int ai = 0; ai < 2; ++ai)
#pragma unroll
            for (int m = 0; m < 4; ++m) rsv[ai][m] = rtab[((u.pm >> 3) & 1) * 256 + ai * HALF + wr * 64 + m * 16 + fr];
        const bool norm = (qkg != nullptr) && which < 2;
        f32x4 g0 = (f32x4){1.f, 1.f, 1.f, 1.f}, g1 = g0;
        if (norm) {
            g0 = *(const f32x4*)(qkg + which * 128 + d0); g1 = *(const f32x4*)(qkg + which * 128 + d0 + 4);
#pragma unroll
            for (int ai = 0; ai < 2; ++ai)
#pragma unroll
                for (int m = 0; m < 4; ++m) { const float rs2 = rsv[ai][m] * rsv[ai][m];
#pragma unroll
                    for (int bj = 0; bj < 2; ++bj) { const f32x4 a0 = acc[ai][bj][m][0], a1 = acc[ai][bj][m][1];
                        float s = ((a0[0] * a0[0] + a0[1] * a0[1]) + (a0[2] * a0[2] + a0[3] * a0[3])) + ((a1[0] * a1[0] + a1[1] * a1[1]) + (a1[2] * a1[2] + a1[3] * a1[3]));
                        s += __shfl_xor(s, 16); s += __shfl_xor(s, 32);
                        if (fq == 0) tab[(ai * HALF + wr * 64 + m * 16 + fr) * 8 + bj * 4 + wc] = s * rs2; } }
            asm volatile("s_waitcnt lgkmcnt(0)" ::: "memory"); __builtin_amdgcn_s_barrier(); asm volatile("" ::: "memory");
        }
#pragma unroll
        for (int ai = 0; ai < 2; ++ai)
#pragma unroll
            for (int m = 0; m < 4; ++m) { const int s = s0 + ai * HALF + m * 16; const float rs = rsv[ai][m] * sc;
#pragma unroll
                for (int bj = 0; bj < 2; ++bj) { const int h = 2 * hp + bj; float rn = rs;
                    if (norm) { const f32x4 t = *(const PG8_LAS f32x4*)(tab + (ai * HALF + wr * 64 + m * 16 + fr) * 8 + bj * 4); rn = rs * __builtin_amdgcn_rsqf(((t[0] + t[1]) + (t[2] + t[3])) * (1.0f / 128.0f) + RMS_EPS); }
                    const f32x4 v0 = acc[ai][bj][m][0] * rn * g0, v1 = acc[ai][bj][m][1] * rn * g1;
                    u32x4 w; w.x = cvt_pk_bf16(v0[0], v0[1]); w.y = cvt_pk_bf16(v0[2], v0[3]); w.z = cvt_pk_bf16(v1[0], v1[1]); w.w = cvt_pk_bf16(v1[2], v1[3]);
                    *(u32x4*)(dst + ((size_t)(b * 16 + h) * 4096 + s) * 128 + d0) = w; } }
    }
};

template <class Epi, class Sched, bool ALIGN_EPI = false, bool SP2 = false>
__device__ __forceinline__ void gemm_phase(PG8_LAS unsigned char* lds, const Gemm g, const Sched& S, const Epi& E) {
    int tid_ = threadIdx.x; asm volatile("" : "+v"(tid_));
    const int tid = tid_, wid = __builtin_amdgcn_readfirstlane(tid >> 6), lane = tid & 63, wr = wid >> 2, wc = wid & 3, fr = lane & 15, fq = lane >> 4;
    const int K = g.K, nt = K / BK;
    unsigned voffA[2], voffB[2];
#pragma unroll
    for (int i = 0; i < 2; ++i) { int R, C; stage_rc(tid * 16 + i * 8192, R, C); const int Rb = Epi::PERM ? ((R & ~31) + perm32(R & 31)) : R;
        voffA[i] = (unsigned)(R * (g.atile ? BK : K) + C) * 2u; voffB[i] = (unsigned)(Rb * (g.btile ? BK : K) + C) * 2u; }
    const size_t kstepA = g.atile ? (size_t)(BM * BK * 2) : (size_t)(BK * 2), kstepB = g.btile ? (size_t)(BM * BK * 2) : (size_t)(BK * 2);
    const size_t hstepA = g.atile ? (size_t)(HALF * BK * 2) : (size_t)HALF * K * 2, hstepB = g.btile ? (size_t)(HALF * BK * 2) : (size_t)HALF * K * 2;
    const size_t tstep = (size_t)BM * K * 2;
    const unsigned ldsw = (unsigned)wid * 1024u;
    const int aoff = lds_byte(wr * 64 + fr, fq * 8), boff = lds_byte(wc * 32 + fr, fq * 8);
#define PG8_SA(b, h) (((b) * 2 + (h)) * HTB)
#define PG8_SB(b, h) ((4 + (b) * 2 + (h)) * HTB)
#define PG8_STAGE(bufoff, gbase, voff) do { _Pragma("unroll") for (int _i = 0; _i < 2; ++_i) \
        __builtin_amdgcn_global_load_lds((const unsigned*)((const char*)(gbase) + (voff)[_i]), (PG8_LAS unsigned*)(lds + (bufoff) + ldsw + _i * 8192), 16, 0, 0); } while (0)
#define PG8_LDA(dst, b, h) do { _Pragma("unroll") for (int m = 0; m < 4; ++m) _Pragma("unroll") for (int k = 0; k < 2; ++k) dst[m][k] = *(const PG8_LAS bf16x8*)(lds + PG8_SA(b, h) + aoff + m * 2048 + k * 1024); } while (0)
#define PG8_LDB(dst, b, h) do { _Pragma("unroll") for (int n = 0; n < 2; ++n) _Pragma("unroll") for (int k = 0; k < 2; ++k) dst[n][k] = *(const PG8_LAS bf16x8*)(lds + PG8_SB(b, h) + boff + n * 2048 + k * 1024); } while (0)
#define PG8_MMA(ai, bj, At, Bt) do { __builtin_amdgcn_s_setprio(1); _Pragma("unroll") for (int m = 0; m < 4; ++m) _Pragma("unroll") for (int n = 0; n < 2; ++n) _Pragma("unroll") for (int k = 0; k < 2; ++k) \
        acc[ai][bj][m][n] = __builtin_amdgcn_mfma_f32_16x16x32_bf16(Bt[n][k], At[m][k], acc[ai][bj][m][n], 0, 0, 0); __builtin_amdgcn_s_setprio(0); } while (0)
#define PG8_WAIT_V(n) asm volatile("s_waitcnt vmcnt(" #n ")" ::: "memory")
#define PG8_WAIT_L(n) asm volatile("s_waitcnt lgkmcnt(" #n ")" ::: "memory")
#define PG8_BAR __builtin_amdgcn_s_barrier()
#define PG8_SCHED __builtin_amdgcn_sched_barrier(0)
    Unit cur, nxt; int ui = 0;
    if (!S.next(0, cur)) return;
    f32x4 acc[2][2][4][2];
    if constexpr (Epi::ACC_INIT) { E.init(acc, cur, wr, wc, fr, fq); } else {
#pragma unroll
    for (int a = 0; a < 2; ++a)
#pragma unroll
        for (int b = 0; b < 2; ++b)
#pragma unroll
            for (int m = 0; m < 4; ++m)
#pragma unroll
                for (int n = 0; n < 2; ++n) acc[a][b][m][n] = (f32x4){0.f, 0.f, 0.f, 0.f}; }
    bf16x8 At[4][2], B0[2][2], B1[2][2];
    const char* cA = (const char*)g.A + (size_t)cur.pm * tstep; const char* cB = (const char*)g.Bt + (size_t)cur.pn * tstep;
    S.a_ready(cur);
    if constexpr (SP2) {
        PG8_STAGE(PG8_SB(0, 0), cB, voffB); PG8_STAGE(PG8_SB(0, 1), cB + hstepB, voffB); PG8_STAGE(PG8_SA(0, 0), cA, voffA); PG8_STAGE(PG8_SA(0, 1), cA + hstepA, voffA);
        if (wr == 1) PG8_BAR;
        PG8_WAIT_V(2); PG8_BAR;
        PG8_STAGE(PG8_SB(1, 0), cB + kstepB, voffB); PG8_STAGE(PG8_SA(1, 0), cA + kstepA, voffA); PG8_STAGE(PG8_SB(1, 1), cB + hstepB + kstepB, voffB);
        PG8_WAIT_V(6); PG8_BAR;
    } else {
        PG8_STAGE(PG8_SB(0, 0), cB, voffB); PG8_STAGE(PG8_SA(0, 0), cA, voffA); PG8_STAGE(PG8_SB(0, 1), cB + hstepB, voffB); PG8_STAGE(PG8_SA(0, 1), cA + hstepA, voffA);
        if (wr == 1) PG8_BAR;
        PG8_WAIT_V(4); PG8_BAR;
        PG8_STAGE(PG8_SB(1, 0), cB + kstepB, voffB); PG8_STAGE(PG8_SA(1, 0), cA + kstepA, voffA); PG8_STAGE(PG8_SB(1, 1), cB + hstepB + kstepB, voffB);
        PG8_WAIT_V(6); PG8_BAR;
    }
    for (;;) {
        const bool has_next = S.next(ui + 1, nxt);
        const char* nA = has_next ? (const char*)g.A + (size_t)nxt.pm * tstep : cA; const char* nB = has_next ? (const char*)g.Bt + (size_t)nxt.pn * tstep : cB;
        for (int t = 0; t < nt; t += 2) {
            const bool last = (t == nt - 2);
            const char* a1 = cA + (size_t)(t + 1) * kstepA;
            const char* a2 = last ? nA : cA + (size_t)(t + 2) * kstepA; const char* b2 = last ? nB : cB + (size_t)(t + 2) * kstepB;
            const char* a3 = a2 + kstepA; const char* b3 = b2 + kstepB;
            if (last && has_next) S.a_ready(nxt);
            if constexpr (SP2) {
            PG8_LDB(B0, 0, 0); PG8_LDB(B1, 0, 1); PG8_SCHED; PG8_LDA(At, 0, 0); PG8_STAGE(PG8_SA(1, 1), a1 + hstepA, voffA);
            PG8_WAIT_V(8); PG8_WAIT_L(0); PG8_BAR; PG8_MMA(0, 0, At, B0); PG8_MMA(0, 1, At, B1); PG8_BAR; PG8_SCHED;
            PG8_LDA(At, 0, 1); PG8_STAGE(PG8_SB(0, 0), b2, voffB); PG8_STAGE(PG8_SB(0, 1), b2 + hstepB, voffB); PG8_STAGE(PG8_SA(0, 0), a2, voffA);
            PG8_WAIT_V(8); PG8_WAIT_L(0); PG8_BAR; PG8_MMA(1, 0, At, B0); PG8_MMA(1, 1, At, B1); PG8_BAR; PG8_SCHED;
            PG8_LDB(B0, 1, 0); PG8_LDB(B1, 1, 1); PG8_SCHED; PG8_LDA(At, 1, 0); PG8_STAGE(PG8_SA(0, 1), a2 + hstepA, voffA);
            PG8_WAIT_V(8); PG8_WAIT_L(0); PG8_BAR; PG8_MMA(0, 0, At, B0); PG8_MMA(0, 1, At, B1); PG8_BAR; PG8_SCHED;
            PG8_LDA(At, 1, 1); PG8_STAGE(PG8_SB(1, 0), b3, voffB); PG8_STAGE(PG8_SB(1, 1), b3 + hstepB, voffB); PG8_STAGE(PG8_SA(1, 0), a3, voffA);
            PG8_WAIT_V(8); PG8_WAIT_L(0); PG8_BAR; PG8_MMA(1, 0, At, B0); PG8_MMA(1, 1, At, B1); PG8_BAR; PG8_SCHED;
            } else {
            PG8_LDB(B0, 0, 0); PG8_SCHED; PG8_LDA(At, 0, 0); PG8_STAGE(PG8_SA(1, 1), a1 + hstepA, voffA);
            PG8_WAIT_L(8); PG8_BAR; PG8_WAIT_L(0); PG8_MMA(0, 0, At, B0); PG8_BAR; PG8_SCHED;
            PG8_LDB(B1, 0, 1); PG8_STAGE(PG8_SB(0, 0), b2, voffB);
            PG8_BAR; PG8_WAIT_L(0); PG8_MMA(0, 1, At, B1); PG8_BAR;
            PG8_LDA(At, 0, 1); PG8_STAGE(PG8_SA(0, 0), a2, voffA);
            PG8_BAR; PG8_WAIT_L(0); PG8_MMA(1, 0, At, B0); PG8_BAR; PG8_SCHED;
            PG8_STAGE(PG8_SB(0, 1), b2 + hstepB, voffB);
            PG8_WAIT_V(6); PG8_BAR; PG8_MMA(1, 1, At, B1); PG8_BAR;
            PG8_LDB(B0, 1, 0); PG8_SCHED; PG8_LDA(At, 1, 0); PG8_STAGE(PG8_SA(0, 1), a2 + hstepA, voffA);
            PG8_WAIT_L(8); PG8_BAR; PG8_WAIT_L(0); PG8_MMA(0, 0, At, B0); PG8_BAR; PG8_SCHED;
            PG8_LDB(B1, 1, 1); PG8_STAGE(PG8_SB(1, 0), b3, voffB);
            PG8_BAR; PG8_WAIT_L(0); PG8_MMA(0, 1, At, B1); PG8_BAR;
            PG8_LDA(At, 1, 1); PG8_STAGE(PG8_SA(1, 0), a3, voffA);
            PG8_BAR; PG8_WAIT_L(0); PG8_MMA(1, 0, At, B0); PG8_BAR; PG8_SCHED;
            PG8_STAGE(PG8_SB(1, 1), b3 + hstepB, voffB);
            PG8_WAIT_V(6); PG8_BAR; PG8_MMA(1, 1, At, B1); PG8_BAR;
            }
        }
        if constexpr (ALIGN_EPI) { if (wr == 0) PG8_BAR; }
        if constexpr (!Epi::AFTER_DRAIN) { E(acc, cur, wr, wc, fr, fq); S.done(cur); }
        if (!has_next) break;
        if constexpr (Epi::ACC_INIT) { E.init(acc, nxt, wr, wc, fr, fq); } else {
#pragma unroll
        for (int a = 0; a < 2; ++a)
#pragma unroll
            for (int b = 0; b < 2; ++b)
#pragma unroll
                for (int m = 0; m < 4; ++m)
#pragma unroll
                    for (int n = 0; n < 2; ++n) acc[a][b][m][n] = (f32x4){0.f, 0.f, 0.f, 0.f}; }
        cur = nxt; cA = nA; cB = nB; ++ui;
        if constexpr (ALIGN_EPI) { if (wr == 1) PG8_BAR; }
    }
    PG8_WAIT_V(0);
    if constexpr (!ALIGN_EPI) { if (wr == 0) PG8_BAR; }
    PG8_BAR;
    if constexpr (Epi::AFTER_DRAIN) { E.fused(acc, cur, wr, wc, fr, fq, lds, wid, lane); S.done(cur); }
#undef PG8_SA
#undef PG8_SB
#undef PG8_STAGE
#undef PG8_LDA
#undef PG8_LDB
#undef PG8_MMA
#undef PG8_WAIT_V
#undef PG8_WAIT_L
#undef PG8_BAR
#undef PG8_SCHED
}
}
namespace att {
typedef unsigned short bf16;
typedef short bf16x8 __attribute__((ext_vector_type(8)));
typedef short s16x4 __attribute__((ext_vector_type(4)));
typedef float f32x16 __attribute__((ext_vector_type(16)));
typedef float f32x4 __attribute__((ext_vector_type(4)));
typedef unsigned u32x4 __attribute__((ext_vector_type(4)));
constexpr int D = 128, NW = 8, QBLK = 32, KVBLK = 64, QB = NW * QBLK, SEQ = 4096, NHEAD = 16, OPITCH = 2048;
constexpr int SHM_V = KVBLK * D * 2, SHM_K = KVBLK * D * 2;
constexpr int LDS_WS = 2 * SHM_V + 2 * SHM_K;
constexpr int LDS_CT = LDS_WS + NW * 64 * 4;
constexpr int LDS_FLAG = LDS_CT + 2 * 64 * 4;
constexpr int LDS_OST = (LDS_FLAG + 64 + 1023) / 1024 * 1024;
constexpr int LDS_BYTES = LDS_OST + NW * 4096;
#define KSWZ(row, colB) ((row) * 256 + ((colB) ^ (((row) & 7) << 4)))
#define SBAR() __builtin_amdgcn_sched_barrier(0)
__device__ __forceinline__ int v_st(int k, int c) { const int kk = (k & ~0xC) | ((k & 4) << 1) | ((k & 8) >> 1); return ((kk >> 3) * 4 + (c >> 5)) * 512 + ((kk & 7) * 32 + (c & 31)) * 2; }
__device__ __forceinline__ int v_rd_base(int lane) { return ((lane & 3) << 3) | (((lane >> 2) & 3) << 6) | (((lane >> 4) & 1) << 5) | (((lane >> 5) & 1) << 8); }
constexpr int v_rd_off(int d0, int ks, int half) { return d0 * 512 + ks * 4096 + half * 2048; }
__device__ __forceinline__ int crow(int r, int hi) { return (r & 3) + 8 * (r >> 2) + 4 * hi; }
__device__ __forceinline__ unsigned cvtpk(float lo, float hi) { unsigned r; asm volatile("v_cvt_pk_bf16_f32 %0, %1, %2" : "=v"(r) : "v"(lo), "v"(hi)); return r; }
template <int KB>
__device__ __forceinline__ void qkt(f32x16& p0, f32x16& p1, const char* K_lds, int r32, int hi, const bf16x8* qr) {
    p0 = f32x16{}; p1 = f32x16{};
    const char* kb[4];
#pragma unroll
    for (int dd = 0; dd < 4; ++dd) kb[dd] = K_lds + KB * SHM_K + KSWZ(r32, (dd * 16 + hi * 8) * 2);
#pragma unroll
    for (int d0 = 0; d0 < 8; ++d0) { const char* a = kb[d0 & 3] + (d0 >> 2) * 128;
        bf16x8 b0 = *reinterpret_cast<const bf16x8*>(a);
        bf16x8 b1 = *reinterpret_cast<const bf16x8*>(a + 32 * 256);
        p0 = __builtin_amdgcn_mfma_f32_32x32x16_bf16(b0, qr[d0], p0, 0, 0, 0);
        p1 = __builtin_amdgcn_mfma_f32_32x32x16_bf16(b1, qr[d0], p1, 0, 0, 0); }
}
template <int VB>
__device__ __forceinline__ void pv_tile(f32x16* o, int vb0, bf16x8 pa0, bf16x8 pa1, bf16x8 pa2, bf16x8 pa3) {
#define TRRD(dst, off) asm volatile("ds_read_b64_tr_b16 %0, %1 offset:%2" : "=&v"(dst) : "v"(vb0), "i"(off) : "memory")
#define PV_D0(d0) do { s16x4 l0, l1, l2, l3, h0, h1, h2, h3; constexpr int b_ = VB * SHM_V + v_rd_off(d0, 0, 0);   \
        TRRD(l0, b_); TRRD(h0, b_ + 2048); TRRD(l1, b_ + 4096); TRRD(h1, b_ + 6144); TRRD(l2, b_ + 8192); TRRD(h2, b_ + 10240); TRRD(l3, b_ + 12288); TRRD(h3, b_ + 14336); \
        asm volatile("s_waitcnt lgkmcnt(0)" ::: "memory"); SBAR();   \
        o[d0] = __builtin_amdgcn_mfma_f32_32x32x16_bf16(pa0, (bf16x8){l0[0], l0[1], l0[2], l0[3], h0[0], h0[1], h0[2], h0[3]}, o[d0], 0, 0, 0);   \
        o[d0] = __builtin_amdgcn_mfma_f32_32x32x16_bf16(pa1, (bf16x8){l1[0], l1[1], l1[2], l1[3], h1[0], h1[1], h1[2], h1[3]}, o[d0], 0, 0, 0);   \
        o[d0] = __builtin_amdgcn_mfma_f32_32x32x16_bf16(pa2, (bf16x8){l2[0], l2[1], l2[2], l2[3], h2[0], h2[1], h2[2], h2[3]}, o[d0], 0, 0, 0);   \
        o[d0] = __builtin_amdgcn_mfma_f32_32x32x16_bf16(pa3, (bf16x8){l3[0], l3[1], l3[2], l3[3], h3[0], h3[1], h3[2], h3[3]}, o[d0], 0, 0, 0); } while (0)
    PV_D0(0); PV_D0(1); PV_D0(2); PV_D0(3);
#undef PV_D0
#undef TRRD
}
__device__ __forceinline__ void pack_p(const f32x16& p0, const f32x16& p1, bf16x8& pa0, bf16x8& pa1, bf16x8& pa2, bf16x8& pa3) {
#define PK4(P, B_, OUT) do { unsigned a0 = cvtpk(P[B_+0], P[B_+1]), a1 = cvtpk(P[B_+2], P[B_+3]);                          \
        unsigned b0 = cvtpk(P[B_+4], P[B_+5]), b1 = cvtpk(P[B_+6], P[B_+7]);                                             \
        auto r0 = __builtin_amdgcn_permlane32_swap(a0, b0, false, false); auto r1 = __builtin_amdgcn_permlane32_swap(a1, b1, false, false); \
        u32x4 w = {r0[0], r1[0], r0[1], r1[1]}; OUT = *reinterpret_cast<bf16x8*>(&w); } while (0)
    PK4(p0, 0, pa0); PK4(p0, 8, pa1); PK4(p1, 0, pa2); PK4(p1, 8, pa3);
#undef PK4
}
template <bool STRICT>
__device__ __forceinline__ void mask_tile(f32x16& p0, f32x16& p1, int dq) {
    const float NEG = -__builtin_inff();
#pragma unroll
    for (int r = 0; r < 16; ++r) { const int c = (r & 3) + 8 * (r >> 2) + (STRICT ? 1 : 0);
        if (dq - c < 0) p0[r] = NEG;
        if (dq - c - 32 < 0) p1[r] = NEG; }
}
constexpr float THR2 = 8.0f * 1.4426950408889634f;

template <int MODE, int BUF>
__device__ __forceinline__ void tile_compute(f32x16 (&o)[4], float& m_reg, float& l_reg, float& R, const bf16x8* qr, const char* K_lds, int vb0, const float* ct, float* al_l,
                                             volatile __attribute__((address_space(3))) unsigned* flags, int kb, int qlo, int qm, int r32, int hi, int wid, int lane, float wthr, float dqw) {
    if (kb > qlo + QBLK - 1) { if (MODE == 1) { if (lane == 0) flags[BUF * 8 + wid] = __all(R < 1e-30f) ? 1u : 0u; } return; }
    if (MODE == 1) { if (__all(R < 1e-30f)) { if (lane == 0) flags[BUF * 8 + wid] = 1u; return; } }
    if (MODE == 0) { if ((ct[BUF * 64 + 63] - dqw) < -wthr) return; }
    f32x16 p0, p1; bf16x8 pa0, pa1, pa2, pa3;
    qkt<BUF>(p0, p1, K_lds, r32, hi, qr);
    if (MODE == 0) {
#pragma unroll
        for (int g = 0; g < 4; ++g) { const f32x4 b0 = *(const f32x4*)(ct + BUF * 64 + 8 * g + 4 * hi), b1 = *(const f32x4*)(ct + BUF * 64 + 32 + 8 * g + 4 * hi);
#pragma unroll
            for (int i = 0; i < 4; ++i) { p0[4 * g + i] += b0[i]; p1[4 * g + i] += b1[i]; } }
        if (kb + KVBLK - 1 > qlo) mask_tile<false>(p0, p1, qm - kb);
        float pmax = p0[0];
#pragma unroll
        for (int r = 1; r < 16; ++r) pmax = fmaxf(pmax, p0[r]);
#pragma unroll
        for (int r = 0; r < 16; ++r) pmax = fmaxf(pmax, p1[r]);
        { auto rr = __builtin_amdgcn_permlane32_swap(__float_as_uint(pmax), __float_as_uint(pmax), false, false);
          pmax = fmaxf(__uint_as_float(rr[0]), __uint_as_float(rr[1])); }
        float mn, alpha;
        if (__all((pmax - m_reg) <= THR2)) { mn = m_reg; alpha = 1.f; }
        else { mn = fmaxf(m_reg, pmax); alpha = __builtin_amdgcn_exp2f(m_reg - mn); m_reg = mn; }
#pragma unroll
        for (int r = 0; r < 16; ++r) { p0[r] = __builtin_amdgcn_exp2f(p0[r] - mn); p1[r] = __builtin_amdgcn_exp2f(p1[r] - mn); }
        if (__any(alpha < 1.f)) { if (hi == 0) al_l[r32] = alpha; asm volatile("s_waitcnt lgkmcnt(0)" ::: "memory");
#pragma unroll
            for (int d_ = 0; d_ < 4; ++d_)
#pragma unroll
                for (int r = 0; r < 16; ++r) o[d_][r] *= al_l[crow(r, hi)]; }
        float ps = 0.f;
#pragma unroll
        for (int r = 0; r < 16; ++r) ps += p0[r];
#pragma unroll
        for (int r = 0; r < 16; ++r) ps += p1[r];
        { auto rr = __builtin_amdgcn_permlane32_swap(__float_as_uint(ps), __float_as_uint(ps), false, false);
          ps = __uint_as_float(rr[0]) + __uint_as_float(rr[1]); }
        l_reg = l_reg * alpha + ps;
    } else {
        if (kb + KVBLK - 1 >= qlo) mask_tile<true>(p0, p1, qm - kb);
        float t1[8], t2[8], t3[8], P[8];
#pragma unroll
        for (int r = 0; r < 16; ++r) { p0[r] = __builtin_amdgcn_rcpf(1.0f + __builtin_amdgcn_exp2f(p0[r])); p1[r] = __builtin_amdgcn_rcpf(1.0f + __builtin_amdgcn_exp2f(p1[r])); }
#pragma unroll
        for (int g = 0; g < 4; ++g) { t3[g] = p0[4 * g + 3]; t2[g] = t3[g] * p0[4 * g + 2]; t1[g] = t2[g] * p0[4 * g + 1]; P[g] = t1[g] * p0[4 * g];
            t3[g + 4] = p1[4 * g + 3]; t2[g + 4] = t3[g + 4] * p1[4 * g + 2]; t1[g + 4] = t2[g + 4] * p1[4 * g + 1]; P[g + 4] = t1[g + 4] * p1[4 * g]; }
        float E[8]; float accp = R;
#pragma unroll
        for (int g = 7; g >= 0; --g) { auto rr = __builtin_amdgcn_permlane32_swap(__float_as_uint(P[g]), __float_as_uint(P[g]), false, false);
            const float pa = __uint_as_float(rr[0]), pb = __uint_as_float(rr[1]);
            const float eb = accp; accp *= pb; const float ea = accp; accp *= pa; E[g] = hi ? eb : ea; }
        R = accp;
#pragma unroll
        for (int g = 0; g < 4; ++g) { float s3 = E[g], s2 = E[g] * t3[g], s1 = E[g] * t2[g], s0 = E[g] * t1[g];
            p0[4 * g + 3] = s3 - p0[4 * g + 3] * s3; p0[4 * g + 2] = s2 - p0[4 * g + 2] * s2; p0[4 * g + 1] = s1 - p0[4 * g + 1] * s1; p0[4 * g] = s0 - p0[4 * g] * s0;
            s3 = E[g + 4]; s2 = E[g + 4] * t3[g + 4]; s1 = E[g + 4] * t2[g + 4]; s0 = E[g + 4] * t1[g + 4];
            p1[4 * g + 3] = s3 - p1[4 * g + 3] * s3; p1[4 * g + 2] = s2 - p1[4 * g + 2] * s2; p1[4 * g + 1] = s1 - p1[4 * g + 1] * s1; p1[4 * g] = s0 - p1[4 * g] * s0; }
        const bool done = __all(R < 1e-30f);
        if (lane == 0) flags[BUF * 8 + wid] = done ? 1u : 0u;
    }
    pack_p(p0, p1, pa0, pa1, pa2, pa3);
    SBAR();
    pv_tile<BUF>(o, vb0, pa0, pa1, pa2, pa3);
}

template <int MODE>
__device__ __forceinline__ void attn_unit(int b, int h, int qb, const bf16* Q, const bf16* K, const bf16* V, bf16* O, const float* c2, float skip_thr, char* lds) {
    int tid_ = threadIdx.x; asm volatile("" : "+v"(tid_));
    const int tid = tid_, wid = __builtin_amdgcn_readfirstlane(tid >> 6), lane = tid & 63, r32 = lane & 31, hi = lane >> 5;
    const size_t hoff = (size_t)(b * NHEAD + h) * SEQ * D;
    const bf16* Qh = Q + hoff; const bf16* Kh = K + hoff; const bf16* Vh = V + hoff; const float* ch = c2 + (size_t)(b * NHEAD + h) * SEQ;
    const int q0 = qb * QB, qlo = q0 + wid * QBLK, qm = qlo + r32 - 4 * hi;
    char* V_lds = lds; char* K_lds = lds + 2 * SHM_V;
    float* ws = (float*)(lds + LDS_WS) + wid * 64; float* li_l = ws, * al_l = ws + 32;
    float* ct = (float*)(lds + LDS_CT); volatile __attribute__((address_space(3))) unsigned* flags = (volatile __attribute__((address_space(3))) unsigned*)(lds + LDS_FLAG);
    const int sr = tid >> 4, sc = (tid & 15) * 8, vst0 = v_st(sr, sc), vst1 = v_st(32 + sr, sc), kws = KSWZ(sr, sc * 2);
    const int vb0 = (int)(uintptr_t)V_lds + v_rd_base(lane);
    bf16x8 qr[8];
#pragma unroll
    for (int d0 = 0; d0 < 8; ++d0) qr[d0] = *reinterpret_cast<const bf16x8*>(Qh + (size_t)(qlo + r32) * D + d0 * 16 + hi * 8);
    float m_reg = -1e30f, l_reg = 0.f, R = 1.0f; f32x16 o[4] = {};
    const float cref = (MODE == 0) ? ch[q0] : 0.f, dqw = (MODE == 0) ? cref - ch[qlo] : 0.f;
    if (MODE == 1) { if (tid < 16) flags[tid] = 0u; }
    bf16x8 sk0, sk1, sv0, sv1; float sct = 0.f, cleft = 0.f;
#define ATT_LOAD(t_) do { const int kb_ = (t_) * KVBLK; sk0 = *reinterpret_cast<const bf16x8*>(Kh + (size_t)(kb_ + sr) * D + sc); sk1 = *reinterpret_cast<const bf16x8*>(Kh + (size_t)(kb_ + 32 + sr) * D + sc); \
        sv0 = *reinterpret_cast<const bf16x8*>(Vh + (size_t)(kb_ + sr) * D + sc); sv1 = *reinterpret_cast<const bf16x8*>(Vh + (size_t)(kb_ + 32 + sr) * D + sc); \
        if (MODE == 0) { if (tid < 64) sct = ch[kb_ + tid]; cleft = ch[kb_ > 0 ? kb_ - 1 : 0]; } } while (0)
#define ATT_STEP(BUF) { const int kb = t * KVBLK; \
        *(bf16x8*)(K_lds + BUF * SHM_K + kws) = sk0; *(bf16x8*)(K_lds + BUF * SHM_K + kws + 32 * 256) = sk1; *(bf16x8*)(V_lds + BUF * SHM_V + vst0) = sv0; *(bf16x8*)(V_lds + BUF * SHM_V + vst1) = sv1; \
        if (MODE == 0) { if (tid < 64) ct[BUF * 64 + tid] = cref - sct; } \
        __syncthreads();                                                       \
        if (MODE == 1) { unsigned all = 1u; _Pragma("unroll") for (int w = 0; w < 8; ++w) all &= flags[(BUF ^ 1) * 8 + w]; if (all) break; } \
        bool more = t > 0; \
        if (MODE == 0) { if (more) more = !((cref - cleft) < -skip_thr); } \
        if (more) ATT_LOAD(t - 1); \
        tile_compute<MODE, BUF>(o, m_reg, l_reg, R, qr, K_lds, vb0, ct, al_l, flags, kb, qlo, qm, r32, hi, wid, lane, skip_thr, dqw); \
        if (!more) break; --t; }
    int t = (q0 + QB) / KVBLK - 1;
    ATT_LOAD(t);
    for (;;) { ATT_STEP(0) ATT_STEP(1) }
#undef ATT_STEP
#undef ATT_LOAD
    float rli[16];
    if (MODE == 0) { if (hi == 0) li_l[r32] = l_reg; asm volatile("s_waitcnt lgkmcnt(0)" ::: "memory");
#pragma unroll
        for (int r = 0; r < 16; ++r) rli[r] = __builtin_amdgcn_rcpf(li_l[crow(r, hi)]); }
    else {
#pragma unroll
        for (int r = 0; r < 16; ++r) rli[r] = 1.0f; }
    bf16* Ow = O + ((size_t)b * SEQ + qlo) * OPITCH + h * D;
    char* ost = lds + LDS_OST + wid * 4096;
#pragma unroll
    for (int pass = 0; pass < 2; ++pass) {
#pragma unroll
        for (int rr = 0; rr < 8; ++rr) { const int r = pass * 8 + rr, lrow = crow(rr, hi);
#pragma unroll
            for (int d0 = 0; d0 < 4; ++d0) { const float v = o[d0][r] * rli[r]; *(unsigned short*)(ost + lrow * 256 + (d0 * 32 + r32) * 2) = (unsigned short)(cvtpk(v, v) & 0xffffu); } }
        asm volatile("s_waitcnt lgkmcnt(0)" ::: "memory");
#pragma unroll
        for (int j = 0; j < 4; ++j) { const int c = lane + 64 * j, lrow = c >> 4, c16 = c & 15; const u32x4 w = *(const u32x4*)(ost + lrow * 256 + c16 * 16);
            *(u32x4*)(Ow + (size_t)(pass * 16 + lrow) * OPITCH + c16 * 8) = w; }
        asm volatile("s_waitcnt lgkmcnt(0)" ::: "memory");
    }
    __syncthreads();
}
#undef KSWZ
#undef SBAR
}

constexpr int NWAVES = 8;
constexpr int DM = 2048, BATCH = 8, SEQ = 4096, DEPTH = 4, NH = 16, HD = 128, DFF = 5632, NFOX = 2, NSB = 2;
constexpr int M = BATCH * SEQ;
constexpr int FOXW = 3 * DM + NH;
constexpr float QK_SCALE_L2E = 0.08838834764831845f * 1.4426950408889634f;
constexpr float LOG2E = 1.4426950408889634f;

constexpr size_t MiB = 1u << 20;
constexpr size_t WS_CTL = 0, CTL_ZERO_BYTES = 1 * MiB;
constexpr size_t SZ_W1 = (size_t)2 * DFF * DM * 2, SZ_W2 = (size_t)DM * DFF * 2, SZ_WQKV = (size_t)3 * DM * DM * 2, SZ_WO = (size_t)DM * DM * 2;
constexpr size_t WS_W1 = 1 * MiB;
constexpr size_t WS_W2 = WS_W1 + 8 * SZ_W1;
constexpr size_t WS_WQKV = WS_W2 + 8 * SZ_W2;
constexpr size_t WS_WO = WS_WQKV + 4 * SZ_WQKV;
constexpr size_t WS_WF = WS_WO + 4 * SZ_WO;
constexpr size_t WS_SSQ = WS_WF + 1 * MiB;
constexpr size_t WS_RSTD = WS_SSQ + (size_t)M * 32 * 4;
constexpr size_t WS_LF = WS_RSTD + 1 * MiB;
constexpr size_t WS_C2 = WS_LF + (size_t)M * NH * 4;
constexpr size_t WS_XB = WS_C2 + (size_t)M * NH * 4;
constexpr size_t WS_Q = WS_XB + (size_t)M * DM * 2, WS_K = WS_Q + (size_t)M * DM * 2, WS_V = WS_K + (size_t)M * DM * 2;
constexpr size_t WS_O = WS_V + (size_t)M * DM * 2;
constexpr size_t WS_ACT = WS_O + (size_t)M * DM * 2;
constexpr size_t WS_END = WS_ACT + (size_t)M * DFF * 2;
constexpr int CW_BAR = 4096;

constexpr int RING_BYTES = 131072;
constexpr int PRO_WAVE_BYTES = 64 * 65 * 4;
constexpr int LDSCTL_OFF = 8 * PRO_WAVE_BYTES;
constexpr int QKTAB_OFF = LDSCTL_OFF + 256;
constexpr int RTAB_OFF = QKTAB_OFF + 8192;
constexpr int LDS_BYTES = 147456;
static_assert(LDSCTL_OFF >= RING_BYTES && RTAB_OFF + 2048 <= LDS_BYTES && att::LDS_BYTES <= RING_BYTES, "LDS map");

#define GAS __attribute__((address_space(1)))
#define LAS __attribute__((address_space(3)))
typedef unsigned short bf16;
typedef unsigned v4u __attribute__((ext_vector_type(4)));
typedef unsigned v2u __attribute__((ext_vector_type(2)));
typedef float f32x4 __attribute__((ext_vector_type(4)));
#define LDS_WAIT() asm volatile("s_waitcnt lgkmcnt(0)" ::: "memory")
__device__ __forceinline__ unsigned f2bf(float f) { unsigned u = __builtin_bit_cast(unsigned, f); return (u + 0x7fffu + ((u >> 16) & 1u)) >> 16; }
__device__ __forceinline__ unsigned pk2(float lo, float hi) { unsigned r; asm("v_cvt_pk_bf16_f32 %0, %1, %2" : "=v"(r) : "v"(lo), "v"(hi)); return r; }
__device__ __forceinline__ float bf2f(unsigned short v) { return __builtin_bit_cast(float, (unsigned)v << 16); }

#define XB_TMO      128
#define XB_XCNT(j)  (256  + 64 * (j))
#define XB_XSUB(j)  (1280 + 64 * (j))
#define XB_XGEN(j)  (2304 + 64 * (j))
#define XB_TOP      3328
#define XB_TOPGEN   3392
#define XCD_BAR_WORDS 3456
#define XB_SPIN_CAP (1u << 18)

__device__ __forceinline__ unsigned xb_ld(unsigned* p)              { return __hip_atomic_load(p, __ATOMIC_RELAXED, __HIP_MEMORY_SCOPE_AGENT); }
__device__ __forceinline__ unsigned xb_add(unsigned* p, unsigned v) { return __hip_atomic_fetch_add(p, v, __ATOMIC_RELAXED, __HIP_MEMORY_SCOPE_AGENT); }
__device__ __forceinline__ unsigned xb_xcc_id() { return (unsigned)__builtin_amdgcn_s_getreg((3 << 11) | 20) & 0xFu; }
#define XB_SPIN(cond, bar) do { unsigned _sp = 0; while (cond) { __builtin_amdgcn_s_sleep(1); \
    if ((++_sp & 255u) == 0u) { if (xb_ld(&(bar)[XB_TMO])) break; if (_sp > XB_SPIN_CAP) { atomicAdd(&(bar)[XB_TMO], 1u); break; } } } } while (0)

struct XcdBarrier {
    unsigned* bar; unsigned x; unsigned nmem;
    volatile LAS unsigned* st;
};

__device__ __forceinline__ XcdBarrier xcd_barrier_post(unsigned* bar, volatile LAS unsigned* st, unsigned nmem) {
    XcdBarrier b; b.bar = bar; b.x = xb_xcc_id(); b.st = st; b.nmem = nmem;
    if (threadIdx.x == 0) (void)xb_add(&bar[XB_XCNT(b.x)], 1u);
    return b;
}
__device__ __forceinline__ void xcd_barrier_complete(unsigned* bar, unsigned x, unsigned G, unsigned& nloc, unsigned& nx) {
    unsigned sum, cnt, mine, sp = 0u;
    for (;;) {
        sum = 0u; cnt = 0u; mine = 0u;
#pragma unroll
        for (unsigned j = 0; j < 16; ++j) { const unsigned c = xb_ld(&bar[XB_XCNT(j)]); sum += c; cnt += (c > 0u) ? 1u : 0u; mine = (j == x) ? c : mine; }
        if (sum == G) break;
        __builtin_amdgcn_s_sleep(1);
        if ((++sp & 255u) == 0u) { if (xb_ld(&bar[XB_TMO])) break; if (sp > XB_SPIN_CAP) { atomicAdd(&bar[XB_TMO], 1u); break; } }
    }
    nloc = mine > 0u ? mine : 1u; nx = cnt > 0u ? cnt : 1u;
}

__device__ __forceinline__ void xcd_barrier(const XcdBarrier& b) {
    asm volatile("s_waitcnt vmcnt(0)" ::: "memory");
    __syncthreads();
    if (threadIdx.x == 0) {
        unsigned* bar = b.bar;
        __builtin_amdgcn_s_waitcnt(0);
        unsigned nloc = b.st[0], nx = b.st[1];
        if (nloc == 0u) { xcd_barrier_complete(bar, b.x, b.nmem, nloc, nx); b.st[0] = nloc; b.st[1] = nx; }
        const unsigned old = xb_add(&bar[XB_XSUB(b.x)], 1u);
        const unsigned gen = old / nloc;
        if (old + 1u == (gen + 1u) * nloc) {
            __builtin_amdgcn_fence(__ATOMIC_RELEASE, "agent");
            asm volatile("s_waitcnt vmcnt(0)" ::: "memory");
            const unsigned og = xb_add(&bar[XB_TOP], 1u);
            const unsigned tg = og / nx;
            if (og + 1u == (tg + 1u) * nx) xb_add(&bar[XB_TOPGEN], 1u);
            else XB_SPIN(xb_ld(&bar[XB_TOPGEN]) == tg, bar);
            __builtin_amdgcn_fence(__ATOMIC_ACQUIRE, "agent");
            xb_add(&bar[XB_XGEN(b.x)], 1u);
            asm volatile("s_waitcnt vmcnt(0)" ::: "memory");
        } else {
            XB_SPIN(xb_ld(&bar[XB_XGEN(b.x)]) == gen, bar);
            __builtin_amdgcn_fence(__ATOMIC_ACQUIRE, "agent");
            asm volatile("s_waitcnt vmcnt(0)" ::: "memory");
        }
    }
    __syncthreads();
}

__device__ __forceinline__ float wave_sum(float v) {
#pragma unroll
    for (int o = 1; o < 64; o <<= 1) v += __shfl_xor(v, o);
    return v;
}
__device__ __forceinline__ void tr_item(const float* W, int ldw, int K, int k0, int n0, const float* g, bf16* WT, int drow0, LAS float* scr, int lane) {
#pragma unroll 4
    for (int i = 0; i < 16; ++i) { const int kk = 4 * i + (lane >> 4), c = (lane & 15) * 4;
        const f32x4 v = *(const GAS f32x4*)(W + (size_t)(k0 + kk) * ldw + n0 + c);
        LAS float* d = scr + kk * 65 + c; d[0] = v.x; d[1] = v.y; d[2] = v.z; d[3] = v.w; }
    LDS_WAIT(); asm volatile("" ::: "memory");
    const int c8 = lane & 7;
    f32x4 ga = (f32x4){1.f, 1.f, 1.f, 1.f}, gb = ga;
    if (g) { ga = *(const f32x4*)(g + k0 + 8 * c8); gb = *(const f32x4*)(g + k0 + 8 * c8 + 4); }
#pragma unroll
    for (int j = 0; j < 8; ++j) { const int n = (lane >> 3) + 8 * j; const LAS float* s = scr + (8 * c8) * 65 + n;
        v4u o; o.x = pk2(s[0 * 65] * ga.x, s[1 * 65] * ga.y); o.y = pk2(s[2 * 65] * ga.z, s[3 * 65] * ga.w); o.z = pk2(s[4 * 65] * gb.x, s[5 * 65] * gb.y); o.w = pk2(s[6 * 65] * gb.z, s[7 * 65] * gb.w);
        const int dr = drow0 + n; *(GAS v4u*)(WT + ((size_t)(dr >> 8) * (K >> 6) + (k0 >> 6)) * 16384 + (dr & 255) * 64 + 8 * c8) = o; }
    LDS_WAIT(); asm volatile("" ::: "memory");
}

#define XBAR() do { XcdBarrier b_; b_.bar = (unsigned*)(args.ws + WS_CTL) + CW_BAR + 8 * XCD_BAR_WORDS; b_.x = xb_xcc_id(); b_.nmem = (unsigned)G; b_.st = (volatile LAS unsigned*)((LAS unsigned char*)lds + LDSCTL_OFF) + 8; xcd_barrier(b_); } while (0)
#define CBAR() do { XcdBarrier b_; b_.bar = (unsigned*)(args.ws + WS_CTL) + CW_BAR + cls * XCD_BAR_WORDS; b_.x = xb_xcc_id(); b_.nmem = (unsigned)GC; b_.st = (volatile LAS unsigned*)((LAS unsigned char*)lds + LDSCTL_OFF) + 10; xcd_barrier(b_); } while (0)
struct Args {
    const float* x; const float* norm_g; const float* ffn_w_in; const float* ffn_w_out; const float* fox_w_in; const float* fox_b_f; const float* fox_qk_g; const float* sb_w_in; const float* w_o;
    float* out; unsigned char* ws;
};

__global__ void __launch_bounds__(NWAVES * 64, 2) mk_fwd(Args args) {
    extern __shared__ __attribute__((aligned(16))) unsigned char lds[];
    LAS unsigned char* ldsl = (LAS unsigned char*)lds;
    const int tid = threadIdx.x, lane = tid & 63, wave = __builtin_amdgcn_readfirstlane(tid >> 6);
    const int G = gridDim.x, bx = blockIdx.x;
    const int vcu = (G % 8 == 0) ? (bx % 8) * (G / 8) + bx / 8 : bx;
    unsigned char* ws = args.ws;
    volatile LAS unsigned* MISC = (volatile LAS unsigned*)(ldsl + LDSCTL_OFF);
    if (tid < 64) MISC[tid] = 0u;
    __syncthreads();
    const int ncls = (G % 8 == 0) ? 8 : 1, cls = bx % ncls, cj = bx / ncls, GC = G / ncls, BPC = BATCH / ncls;
    (void)xcd_barrier_post((unsigned*)(ws + WS_CTL) + CW_BAR + 8 * XCD_BAR_WORDS, MISC + 8, (unsigned)G);
    (void)xcd_barrier_post((unsigned*)(ws + WS_CTL) + CW_BAR + cls * XCD_BAR_WORDS, MISC + 10, (unsigned)GC);

    bf16* W1T = (bf16*)(ws + WS_W1); bf16* W2T = (bf16*)(ws + WS_W2); bf16* WQKVT = (bf16*)(ws + WS_WQKV); bf16* WOT = (bf16*)(ws + WS_WO);
    bf16* WFT = (bf16*)(ws + WS_WF); float* SSQ = (float*)(ws + WS_SSQ); float* RSTD = (float*)(ws + WS_RSTD); float* LF = (float*)(ws + WS_LF); float* C2 = (float*)(ws + WS_C2);
    bf16* XB = (bf16*)(ws + WS_XB); bf16* QB_ = (bf16*)(ws + WS_Q); bf16* KB_ = (bf16*)(ws + WS_K); bf16* VB_ = (bf16*)(ws + WS_V); bf16* OB = (bf16*)(ws + WS_O); bf16* ACT = (bf16*)(ws + WS_ACT);
    const int gw = vcu * NWAVES + wave, NGW = G * NWAVES;

    {
        LAS float* scr = (LAS float*)(ldsl + wave * PRO_WAVE_BYTES);
        constexpr int I_W1 = 32 * 176, I_W2 = 88 * 32, I_QKV = 32 * 96, I_WO = 32 * 32;
        constexpr int NITEMS = 8 * I_W1 + 8 * I_W2 + 4 * I_QKV + 4 * I_WO;
        for (int it = gw; it < NITEMS; it += NGW) {
            int r = it;
            if (r < 8 * I_W1) { const int mi = r / I_W1, q = r % I_W1, kb = q / 176, nb = q % 176, layer = mi >> 1, f = mi & 1;
                const int n0 = nb * 64, half = n0 / DFF, j0 = n0 % DFF, drow = 256 * (j0 / 128) + 128 * half + (j0 % 128);
                tr_item(args.ffn_w_in + (size_t)mi * DM * 2 * DFF, 2 * DFF, DM, kb * 64, n0, args.norm_g + (size_t)(layer * 3 + (f ? 2 : 0)) * DM, W1T + (size_t)mi * 2 * DFF * DM, drow, scr, lane); continue; }
            r -= 8 * I_W1;
            if (r < 8 * I_W2) { const int mi = r / I_W2, q = r % I_W2, kb = q / 32, nb = q % 32;
                tr_item(args.ffn_w_out + (size_t)mi * DFF * DM, DM, DFF, kb * 64, nb * 64, nullptr, W2T + (size_t)mi * DM * DFF, nb * 64, scr, lane); continue; }
            r -= 8 * I_W2;
            if (r < 4 * I_QKV) { const int layer = r / I_QKV, q = r % I_QKV, kb = q / 96, nb = q % 96, j = layer >> 1;
                const float* W = (layer & 1) ? args.sb_w_in + (size_t)j * DM * 3 * DM : args.fox_w_in + (size_t)j * DM * FOXW; const int ldw = (layer & 1) ? 3 * DM : FOXW;
                tr_item(W, ldw, DM, kb * 64, nb * 64, args.norm_g + (size_t)(layer * 3 + 1) * DM, WQKVT + (size_t)layer * 3 * DM * DM, nb * 64, scr, lane); continue; }
            r -= 4 * I_QKV;
            { const int layer = r / I_WO, q = r % I_WO, kb = q / 32, nb = q % 32;
                tr_item(args.w_o + (size_t)layer * DM * DM, DM, DM, kb * 64, nb * 64, nullptr, WOT + (size_t)layer * DM * DM, nb * 64, scr, lane); }
        }
        for (int i = gw * 64 + lane; i < NFOX * NH * DM; i += NGW * 64) { const int j = i / (DM * NH), h = (i / DM) % NH, k = i % DM;
            WFT[i] = (bf16)f2bf(args.norm_g[(size_t)((2 * j) * 3 + 1) * DM + k] * args.fox_w_in[(size_t)j * DM * FOXW + (size_t)k * FOXW + 3 * DM + h]); }
        for (int m = gw; m < M; m += NGW) {
            const GAS f32x4* xr = (const GAS f32x4*)(args.x + (size_t)m * DM) + lane; GAS v2u* o8 = (GAS v2u*)(XB + (size_t)m * DM) + lane; float s = 0.f;
#pragma unroll
            for (int j = 0; j < 8; ++j) { const f32x4 v = xr[64 * j]; s += (v.x * v.x + v.y * v.y) + (v.z * v.z + v.w * v.w); v2u w; w.x = pk2(v.x, v.y); w.y = pk2(v.z, v.w); o8[64 * j] = w; }
            s = wave_sum(s);
            if (lane == 0) RSTD[m] = 1.0f / sqrtf(s * (1.0f / DM) + 1e-6f);
        }
    }
    XBAR();

#define RSTD_PASS(GATE, jfox) do { int lane_o = threadIdx.x & 63; asm volatile("" : "+v"(lane_o)); const int ln = lane_o; \
        for (int tile = cj * NWAVES + wave; tile < BPC * SEQ / 16; tile += GC * NWAVES) { const int r0 = cls * BPC * SEQ + tile * 16; \
            const f32x4* p = (const f32x4*)(SSQ + (size_t)(r0 + (ln >> 2)) * 32 + (ln & 3) * 8); const f32x4 sv = p[0] + p[1]; float t = (sv[0] + sv[1]) + (sv[2] + sv[3]); \
            t += __shfl_xor(t, 1); t += __shfl_xor(t, 2); const float rs = 1.0f / sqrtf(t * (1.0f / DM) + 1e-6f); if ((ln & 3) == 0) RSTD[r0 + (ln >> 2)] = rs; \
            if (GATE) { const bf16* ap = XB + (size_t)(r0 + (ln & 15)) * DM + 8 * (ln >> 4); const bf16* bp = WFT + ((size_t)(jfox) * NH + (ln & 15)) * DM + 8 * (ln >> 4); \
                pg8::f32x4 ga = (pg8::f32x4){0.f, 0.f, 0.f, 0.f}; \
                _Pragma("unroll 8") for (int kk = 0; kk < DM / 32; ++kk) { const pg8::bf16x8 a = *(const pg8::bf16x8*)(ap + kk * 32), bq = *(const pg8::bf16x8*)(bp + kk * 32); ga = __builtin_amdgcn_mfma_f32_16x16x32_bf16(a, bq, ga, 0, 0, 0); } \
                const float bfv = args.fox_b_f[(jfox) * NH + (ln & 15)]; f32x4 o; \
                _Pragma("unroll") for (int r = 0; r < 4; ++r) { const float rr = __shfl(rs, 4 * (4 * (ln >> 4) + r)); const float v = ga[r] * rr + bfv; o[r] = fminf(v, 0.f) - log1pf(expf(-fabsf(v))); } \
                const int bb = r0 / SEQ, ss = r0 % SEQ + 4 * (ln >> 4); *(f32x4*)(LF + ((size_t)bb * NH + (ln & 15)) * SEQ + ss) = o; } } } while (0)
    for (int blk = 0; blk < 3 * DEPTH; ++blk) {
        const int layer = blk / 3, sub = blk % 3;
        const bf16* rA; const bf16* rB; int rK, rAt; float ralpha, rinv;
        if (sub != 1) {
            const int mi = layer * 2 + (sub >> 1);
            {
                pg8::Gemm g{XB, W1T + (size_t)mi * 2 * DFF * DM, M, 2 * DFF, DM, 0, 1}; pg8::RstdOrder S; S.init(M, 2 * DFF, G, bx); S.rstd = RSTD; S.tab = ldsl + RTAB_OFF;
                pg8::EpiSwiGLU E{ACT, DFF, (const PG8_LAS float*)(ldsl + RTAB_OFF)};
                pg8::gemm_phase<pg8::EpiSwiGLU, pg8::RstdOrder, true, true>(ldsl, g, S, E);
            }
            CBAR();
            rA = ACT; rB = W2T + (size_t)mi * DM * DFF; rK = DFF; rAt = 1; ralpha = 0.5f; rinv = 2.0f;
        } else {
            const int fox = !(layer & 1), j = layer >> 1;
            {
                pg8::Gemm g{XB, WQKVT + (size_t)layer * 3 * DM * DM, M, 3 * DM, DM, 0, 1}; pg8::RstdOrder S; S.init(M, 3 * DM, G, bx); S.rstd = RSTD; S.tab = ldsl + RTAB_OFF;
                pg8::EpiQKV E{QB_, (size_t)M * DM, (const PG8_LAS float*)(ldsl + RTAB_OFF), QK_SCALE_L2E, fox ? args.fox_qk_g + (size_t)j * 2 * HD : nullptr, (PG8_LAS float*)(ldsl + QKTAB_OFF)};
                pg8::gemm_phase<pg8::EpiQKV, pg8::RstdOrder, true, true>(ldsl, g, S, E);
            }
            CBAR();
            float skip_thr = 0.f;
            if (fox) {
                int lane_o = threadIdx.x & 63; asm volatile("" : "+v"(lane_o)); const int lane = lane_o;
                if (cj * NWAVES + wave < BPC * NH) { const int sq_ = cls * BPC * NH + cj * NWAVES + wave; const float* src = LF + (size_t)sq_ * SEQ + lane * 64; float* dst = C2 + (size_t)sq_ * SEQ + lane * 64;
                    float v[64]; float run = 0.f;
#pragma unroll
                    for (int i = 0; i < 16; ++i) { const f32x4 t = *(const f32x4*)(src + 4 * i); run += t.x; v[4 * i] = run; run += t.y; v[4 * i + 1] = run; run += t.z; v[4 * i + 2] = run; run += t.w; v[4 * i + 3] = run; }
                    float incl = run;
#pragma unroll
                    for (int o = 1; o < 64; o <<= 1) { const float t = __shfl_up(incl, o); if (lane >= o) incl += t; }
                    const float pre = incl - run;
#pragma unroll
                    for (int i = 0; i < 16; ++i) { f32x4 t; t.x = (v[4 * i] + pre) * LOG2E; t.y = (v[4 * i + 1] + pre) * LOG2E; t.z = (v[4 * i + 2] + pre) * LOG2E; t.w = (v[4 * i + 3] + pre) * LOG2E; *(f32x4*)(dst + 4 * i) = t; } }
                CBAR();
                const float* qkg = args.fox_qk_g + (size_t)j * 2 * HD;
                float gq = fmaxf(fabsf(qkg[lane]), fabsf(qkg[lane + 64])), gk = fmaxf(fabsf(qkg[HD + lane]), fabsf(qkg[HD + lane + 64]));
#pragma unroll
                for (int o_ = 1; o_ < 64; o_ <<= 1) { gq = fmaxf(gq, __shfl_xor(gq, o_)); gk = fmaxf(gk, __shfl_xor(gk, o_)); }
                skip_thr = (30.0f + 2.0f * 11.3137085f * 1.02f * gq * gk) * LOG2E; }
            for (int i2 = 0; ; ++i2) { const int L = (i2 >> 1) * GC + cj; if (L >= BPC * NH * 8) break;
                const int bh = cls * BPC * NH + (L >> 3), x = (i2 & 1) ? 15 - (L & 7) : (L & 7), b = bh / NH, h = bh % NH;
                if (fox) att::attn_unit<0>(b, h, x, QB_, KB_, VB_, OB, C2, skip_thr, (char*)lds);
                else     att::attn_unit<1>(b, h, x, QB_, KB_, VB_, OB, C2, 0.f, (char*)lds); }
            CBAR();
            rA = OB; rB = WOT + (size_t)layer * DM * DM; rK = DM; rAt = 0; ralpha = 1.0f; rinv = 1.0f;
        }
        {
            pg8::Gemm g{rA, rB, M, DM, rK, rAt, 1}; pg8::StaticOrder S; S.init(M, DM, G, bx, 0, 0, 4);
            pg8::EpiResid E{args.out, XB, SSQ, ralpha, rinv, DM, blk == 3 * DEPTH - 1};
            pg8::gemm_phase<pg8::EpiResid, pg8::StaticOrder, true, true>(ldsl, g, S, E);
        }
        if (blk == 3 * DEPTH - 1) break;
        CBAR();
        { const bool gate = (sub == 0) && !(layer & 1); const int jf = layer >> 1; RSTD_PASS(gate, jf); }
        CBAR();
    }
}

extern "C" void kernel_launch(void* const* d_in, const int* in_sizes, int n_in, void* d_out, int out_size, void* d_ws, size_t ws_size, hipStream_t stream) {
    static int grid = 0;
    if (grid == 0) {
        if (n_in != 9 || in_sizes[0] != M * DM || out_size != M * DM || ws_size < WS_END) { fprintf(stderr, "kernel_launch: unexpected shapes (n_in %d, in0 %d, out %d, ws %zu < %zu)\n", n_in, n_in > 0 ? in_sizes[0] : -1, out_size, ws_size, (size_t)WS_END); grid = -1; return; }
        int dev = 0, cus = 0, per_cu = 0;
        if (hipGetDevice(&dev) != hipSuccess || hipDeviceGetAttribute(&cus, hipDeviceAttributeMultiprocessorCount, dev) != hipSuccess) { grid = -1; return; }
        if (hipFuncSetAttribute((const void*)mk_fwd, hipFuncAttributeMaxDynamicSharedMemorySize, LDS_BYTES) != hipSuccess) { fprintf(stderr, "kernel_launch: hipFuncSetAttribute failed\n"); grid = -1; return; }
        if (hipOccupancyMaxActiveBlocksPerMultiprocessor(&per_cu, (const void*)mk_fwd, NWAVES * 64, LDS_BYTES) != hipSuccess || per_cu < 1) fprintf(stderr, "kernel_launch: occupancy query reports %d\n", per_cu);
        (void)hipGetLastError();
        grid = cus;
    }
    if (grid < 0) return;
    if (hipMemsetAsync((char*)d_ws + WS_CTL, 0, CTL_ZERO_BYTES, stream) != hipSuccess) return;
    Args a{};
    a.x = (const float*)d_in[0]; a.norm_g = (const float*)d_in[1]; a.ffn_w_in = (const float*)d_in[2]; a.ffn_w_out = (const float*)d_in[3]; a.fox_w_in = (const float*)d_in[4];
    a.fox_b_f = (const float*)d_in[5]; a.fox_qk_g = (const float*)d_in[6]; a.sb_w_in = (const float*)d_in[7]; a.w_o = (const float*)d_in[8];
    a.out = (float*)d_out; a.ws = (unsigned char*)d_ws;
    hipLaunchKernelGGL(mk_fwd, dim3(grid), dim3(NWAVES * 64), LDS_BYTES, stream, a);
}
```
